# Optimizing an MI355X kernel written in HIP

```python
import math
import jax, jax.numpy as jnp
from jax import lax
import numpy as np

D_MODEL = 1024
BATCH = 16
SEQ = 2048
DEPTH = 4

GRID_W = 64
CTX_LEN = 256
HEAD_DIM = 64
A_HEADS = D_MODEL // 128
A_KV_HEADS = 2
A_GROUP = A_HEADS // A_KV_HEADS
CONV_CH = D_MODEL // 4
CONV_WIDTH = 3
C_HEADS = D_MODEL // 256
C_QK_DIM = 32
C_V_DIM = 2 * C_QK_DIM
MIX_A = A_HEADS * HEAD_DIM
MIX_B = CONV_CH
MIX_C = C_HEADS * C_V_DIM
MIX_WIDTH = MIX_A + MIX_B + MIX_C
IN_SPLITS = (MIX_A, A_KV_HEADS * HEAD_DIM, A_KV_HEADS * HEAD_DIM,
             CONV_CH, CONV_CH, CONV_CH,
             C_HEADS * 2 * C_QK_DIM, C_HEADS * 2 * C_QK_DIM, MIX_C)
IN_WIDTH = sum(IN_SPLITS)
IN_OFFSETS = tuple(int(v) for v in np.cumsum(IN_SPLITS)[:-1])
D_FF = ((8 * D_MODEL // 3 + 127) // 128) * 128
N_EXPERTS = 8
TOP_K = 2
N_DENSE = (DEPTH + 1) // 2
N_MOE = DEPTH // 2
Q_BLOCK = 128
ROPE_THETA = 10000.0
EPS = 1e-6

kernel_name = "hybrid_dit_parallel_heads_moe"


def rms_norm(x, g):
    xf = x.astype(jnp.float32)
    y = xf * lax.rsqrt(jnp.mean(xf * xf, axis=-1, keepdims=True) + EPS)
    return (y * g.astype(jnp.float32)).astype(x.dtype)


def rope_1d(x, pos):
    n = x.shape[-1]
    inv = ROPE_THETA ** (-jnp.arange(0, n, 2, dtype=jnp.float32) / n)
    ang = pos.astype(jnp.float32)[:, None] * inv[None, :]
    shape = (1, x.shape[1]) + (1,) * (x.ndim - 3) + (n // 2,)
    cos = jnp.cos(ang).reshape(shape)
    sin = jnp.sin(ang).reshape(shape)
    xf = x.astype(jnp.float32)
    x1, x2 = xf[..., : n // 2], xf[..., n // 2:]
    return jnp.concatenate([x1 * cos - x2 * sin, x2 * cos + x1 * sin], axis=-1).astype(x.dtype)


def axial_rope(x, row, col):
    half = x.shape[-1] // 2
    return jnp.concatenate([rope_1d(x[..., :half], row), rope_1d(x[..., half:], col)], axis=-1)


def gqa_attend(q, k, v):
    s = jnp.einsum('bqkgd,bskd->bkgqs', q, k).astype(jnp.float32) * (q.shape[-1] ** -0.5)
    p = jax.nn.softmax(s, axis=-1).astype(v.dtype)
    return jnp.einsum('bkgqs,bskd->bqkgd', p, v)


def diff_attend(q, k, v, lam):
    s = jnp.einsum('bqhcd,bshcd->bhcqs', q, k).astype(jnp.float32) * (q.shape[-1] ** -0.5)
    p = jax.nn.softmax(s, axis=-1)
    a = p[:, :, 0] - lam * p[:, :, 1]
    return jnp.einsum('bhqs,bshd->bqhd', a.astype(v.dtype), v)


def sweep_query_blocks(fn, q):
    b, n = q.shape[:2]
    qb = jnp.moveaxis(q.reshape((b, n // Q_BLOCK, Q_BLOCK) + q.shape[2:]), 1, 0)
    out = jnp.moveaxis(lax.map(fn, qb), 0, 1)
    return out.reshape((b, n) + out.shape[3:])


def short_conv(z, w):
    pad = (CONV_WIDTH - 1) // 2
    n = z.shape[1]
    zp = jnp.pad(z, ((0, 0), (pad, CONV_WIDTH - 1 - pad), (0, 0)))
    y = w[0] * zp[:, 0:n]
    for j in range(1, CONV_WIDTH):
        y = y + w[j] * zp[:, j:j + n]
    return y


def mixer_inputs(p, a_qg, a_kg, d_qg, d_kg, pos):
    b, n = p.shape[:2]
    aq, ak, av, bu, bb, bc, dq, dk, dv = jnp.split(p, IN_OFFSETS, axis=-1)
    aq = rms_norm(aq.reshape(b, n, A_KV_HEADS, A_GROUP, HEAD_DIM), a_qg)
    ak = rms_norm(ak.reshape(b, n, A_KV_HEADS, HEAD_DIM), a_kg)
    av = av.reshape(b, n, A_KV_HEADS, HEAD_DIM)
    dq = rms_norm(dq.reshape(b, n, C_HEADS, 2, C_QK_DIM), d_qg)
    dk = rms_norm(dk.reshape(b, n, C_HEADS, 2, C_QK_DIM), d_kg)
    dv = dv.reshape(b, n, C_HEADS, C_V_DIM)
    if pos is not None:
        row, col = pos
        aq = axial_rope(aq, row, col)
        ak = axial_rope(ak, row, col)
        dq = axial_rope(dq, row, col)
        dk = axial_rope(dk, row, col)
    return aq, ak, av, bu, bb, bc, dq, dk, dv


def merge_heads(a, bo, d, subln, lam_init, w_o):
    b, n = bo.shape[:2]
    d = rms_norm(d, subln) * (1.0 - lam_init)
    y = jnp.concatenate([a.reshape(b, n, MIX_A), bo, d.reshape(b, n, MIX_C)], axis=-1)
    return y @ w_o


def swiglu(h, wg, wu, wd):
    return (jax.nn.silu(h @ wg) * (h @ wu)) @ wd


def moe_swiglu(h, rw, rb, wg, wu, wd):
    logits = (h @ rw).astype(jnp.float32) + rb.astype(jnp.float32)
    top_v, top_i = lax.top_k(logits, TOP_K)
    gates = jax.nn.softmax(top_v, axis=-1)
    combine = jnp.sum(jax.nn.one_hot(top_i, N_EXPERTS, dtype=jnp.float32) * gates[..., None], axis=-2)
    combine = combine.astype(h.dtype)
    out = jnp.zeros_like(h)
    for e in range(N_EXPERTS):
        out = out + combine[..., e:e + 1] * swiglu(h, wg[e], wu[e], wd[e])
    return out


def channel_mix(h, l, dense_w_gate, dense_w_up, dense_w_down, router_w, router_b,
                moe_w_gate, moe_w_up, moe_w_down):
    i = l // 2
    if l % 2 == 0:
        return swiglu(h, dense_w_gate[i], dense_w_up[i], dense_w_down[i])
    return moe_swiglu(h, router_w[i], router_b[i], moe_w_gate[i], moe_w_up[i], moe_w_down[i])


def setup_inputs(seed: int = 0) -> dict:
    key = jax.random.key(seed)
    ks = jax.random.split(key, 32)
    f32 = jnp.float32
    nrm = lambda k, shape, s: jax.random.normal(k, shape, f32) * s
    D = D_MODEL
    return {
        "x": nrm(ks[0], (BATCH, SEQ, D), 1.0),
        "c": nrm(ks[1], (BATCH, D), 1.0),
        "ctx": nrm(ks[2], (BATCH, CTX_LEN, D), 1.0),
        "c_ctx": nrm(ks[3], (D,), 1.0),
        "w_ada": nrm(ks[4], (DEPTH, D, 6 * D), 0.5 * D ** -0.5),
        "b_ada": nrm(ks[5], (DEPTH, 6 * D), 0.02),
        "norm_mix": 1.0 + nrm(ks[6], (DEPTH, D), 0.02),
        "norm_ffn": 1.0 + nrm(ks[7], (DEPTH, D), 0.02),
        "w_in": nrm(ks[8], (DEPTH, D, IN_WIDTH), D ** -0.5),
        "w_out": nrm(ks[9], (DEPTH, MIX_WIDTH, D), MIX_WIDTH ** -0.5),
        "a_q_gain": 1.0 + nrm(ks[10], (DEPTH, HEAD_DIM), 0.02),
        "a_k_gain": 1.0 + nrm(ks[11], (DEPTH, HEAD_DIM), 0.02),
        "d_q_gain": 1.0 + nrm(ks[12], (DEPTH, C_QK_DIM), 0.02),
        "d_k_gain": 1.0 + nrm(ks[13], (DEPTH, C_QK_DIM), 0.02),
        "conv_w": nrm(ks[14], (DEPTH, CONV_WIDTH, CONV_CH), CONV_WIDTH ** -0.5),
        "diff_lambda": nrm(ks[15], (DEPTH, 4, C_QK_DIM), 0.1),
        "diff_subln": 1.0 + nrm(ks[16], (DEPTH, C_V_DIM), 0.02),
        "dense_w_gate": nrm(ks[17], (N_DENSE, D, D_FF), D ** -0.5),
        "dense_w_up": nrm(ks[18], (N_DENSE, D, D_FF), D ** -0.5),
        "dense_w_down": nrm(ks[19], (N_DENSE, D_FF, D), D_FF ** -0.5),
        "router_w": nrm(ks[20], (N_MOE, D, N_EXPERTS), D ** -0.5),
        "router_b": nrm(ks[21], (N_MOE, N_EXPERTS), 0.01),
        "moe_w_gate": nrm(ks[22], (N_MOE, N_EXPERTS, D, D_FF), D ** -0.5),
        "moe_w_up": nrm(ks[23], (N_MOE, N_EXPERTS, D, D_FF), D ** -0.5),
        "moe_w_down": nrm(ks[24], (N_MOE, N_EXPERTS, D_FF, D), D_FF ** -0.5),
    }


def reference(x, c, ctx, c_ctx, w_ada, b_ada, norm_mix, norm_ffn, w_in, w_out,
              a_q_gain, a_k_gain, d_q_gain, d_k_gain, conv_w, diff_lambda, diff_subln,
              dense_w_gate, dense_w_up, dense_w_down, router_w, router_b,
              moe_w_gate, moe_w_up, moe_w_down):
    n_tok = x.shape[1]
    ROWS = n_tok // GRID_W
    row = jnp.repeat(jnp.arange(ROWS, dtype=jnp.int32), GRID_W)
    col = jnp.tile(jnp.arange(GRID_W, dtype=jnp.int32), ROWS)
    s_lat = jax.nn.silu(c)
    s_ctx = jax.nn.silu(c_ctx)
    xc = ctx
    for l in range(DEPTH):
        last = l == DEPTH - 1
        lam_init = 0.8 - 0.6 * math.exp(-0.3 * l)
        mod = (s_lat @ w_ada[l] + b_ada[l])[:, None, :]
        mod_c = s_ctx @ w_ada[l] + b_ada[l]
        sh1, sc1, g1, sh2, sc2, g2 = jnp.split(mod, 6, axis=-1)
        csh1, csc1, cg1, csh2, csc2, cg2 = jnp.split(mod_c, 6, axis=-1)
        lam_p = diff_lambda[l].astype(jnp.float32)
        lam = (jnp.exp(jnp.sum(lam_p[0] * lam_p[1])) - jnp.exp(jnp.sum(lam_p[2] * lam_p[3]))
               + lam_init)

        h = rms_norm(x, norm_mix[l]) * (1.0 + sc1) + sh1
        hc = rms_norm(xc, norm_mix[l]) * (1.0 + csc1) + csh1
        aq, ak, av, bu, bb, bc, dq, dk, dv = mixer_inputs(
            h @ w_in[l], a_q_gain[l], a_k_gain[l], d_q_gain[l], d_k_gain[l], (row, col))
        caq, cak, cav, cbu, cbb, cbc, cdq, cdk, cdv = mixer_inputs(
            hc @ w_in[l], a_q_gain[l], a_k_gain[l], d_q_gain[l], d_k_gain[l], None)
        ak_all = jnp.concatenate([ak, cak], axis=1)
        av_all = jnp.concatenate([av, cav], axis=1)
        dk_all = jnp.concatenate([dk, cdk], axis=1)
        dv_all = jnp.concatenate([dv, cdv], axis=1)
        a_out = sweep_query_blocks(lambda qb: gqa_attend(qb, ak_all, av_all), aq)
        d_out = sweep_query_blocks(lambda qb: diff_attend(qb, dk_all, dv_all, lam), dq)
        b_out = bb * short_conv(bc * bu, conv_w[l])
        x = x + g1 * merge_heads(a_out, b_out, d_out, diff_subln[l], lam_init, w_out[l])
        if not last:
            ca = gqa_attend(caq, cak, cav)
            cd = diff_attend(cdq, cdk, cdv, lam)
            cb = cbb * short_conv(cbc * cbu, conv_w[l])
            xc = xc + cg1 * merge_heads(ca, cb, cd, diff_subln[l], lam_init, w_out[l])

        h2 = rms_norm(x, norm_ffn[l]) * (1.0 + sc2) + sh2
        x = x + g2 * channel_mix(h2, l, dense_w_gate, dense_w_up, dense_w_down,
                                 router_w, router_b, moe_w_gate, moe_w_up, moe_w_down)
        if not last:
            hc2 = rms_norm(xc, norm_ffn[l]) * (1.0 + csc2) + csh2
            xc = xc + cg2 * channel_mix(hc2, l, dense_w_gate, dense_w_up, dense_w_down,
                                        router_w, router_b, moe_w_gate, moe_w_up, moe_w_down)
    return x
```

```cpp
#include <hip/hip_runtime.h>
#include <cstdio>
#include <cstdint>

typedef unsigned short bf16;
typedef float f32x4 __attribute__((ext_vector_type(4)));
typedef unsigned u32x4 __attribute__((ext_vector_type(4)));
typedef unsigned u32x2 __attribute__((ext_vector_type(2)));

constexpr int D = 1024, NB = 16, SEQ = 2048, CTX = 256, ML = NB * SEQ, MC = NB * CTX, MT = ML + MC;
constexpr int NIN = 2304, DFF = 2816, NE = 8, DEPTH = 4;
constexpr float EPS = 1e-6f;
constexpr float LOG2E = 1.4426950408889634f;
constexpr float C2A = 0.125f * LOG2E;
constexpr float C2C = 0.17677669529663687f * LOG2E;

constexpr size_t MiB = 1u << 20;
constexpr size_t WS_CTL = 0;
constexpr size_t WS_MOD = 1 * MiB;
constexpr size_t WS_TAB = 3 * MiB;
constexpr size_t WS_MOE = 4 * MiB;
constexpr size_t WS_XB = 233 * MiB;
constexpr size_t WS_H = 305 * MiB;
constexpr size_t WS_P = 380 * MiB;
constexpr size_t WS_RSL = 377 * MiB;
constexpr size_t WS_END = 798 * MiB;
constexpr int CW_CNT = 64;
constexpr int TB_COSA = 0, TB_SINA = 1024, TB_COSC = 2048, TB_SINC = 2560, TB_LAM = 3072  , TB_F8 = 3200  ;
constexpr size_t MOE_LIST = 0;
constexpr size_t MOE_GATE = (size_t)2 * 8 * MT * 4;

__device__ __forceinline__ float bf2f(unsigned short h) { return __builtin_bit_cast(float, (unsigned)h << 16); }
__device__ __forceinline__ unsigned f2bf(float f) { unsigned u = __builtin_bit_cast(unsigned, f); return (u + 0x7fffu + ((u >> 16) & 1u)) >> 16; }
__device__ __forceinline__ unsigned pk2(float lo, float hi) { return f2bf(lo) | (f2bf(hi) << 16); }
__device__ __forceinline__ int lane_now() { int l; asm volatile("v_mbcnt_lo_u32_b32 %0, -1, 0\n\tv_mbcnt_hi_u32_b32 %0, -1, %0" : "=v"(l)); return l; }
template <int M> __device__ __forceinline__ float shx(float v) {
    return __builtin_bit_cast(float, __builtin_amdgcn_ds_swizzle(__builtin_bit_cast(int, v), (M << 10) | 0x1F)); }
__device__ __forceinline__ void halves32(float v, float& lo, float& hi) {
    float a = v, b = v; asm("s_nop 1\n\tv_permlane32_swap_b32 %0, %1" : "+v"(a), "+v"(b));
    lo = a; hi = b; }
__device__ __forceinline__ float sum32(float v) { float lo, hi; halves32(v, lo, hi); return lo + hi; }
__device__ __forceinline__ float max32(float v) { float lo, hi; halves32(v, lo, hi); return fmaxf(lo, hi); }
template <int CTRL> __device__ __forceinline__ float dppf(float v) { return __builtin_bit_cast(float, __builtin_amdgcn_update_dpp(0, __builtin_bit_cast(int, v), CTRL, 0xF, 0xF, false)); }
__device__ __forceinline__ void halves16(float v, float& ev, float& od) {
    float a = v, b = v; asm("s_nop 1\n\tv_permlane16_swap_b32 %0, %1" : "+v"(a), "+v"(b)); ev = a; od = b; }
__device__ __forceinline__ float wave_sum(float v) { v += dppf<0xB1>(v); v += dppf<0x4E>(v); v += dppf<0x141>(v); v += dppf<0x140>(v); float a, c; halves16(v, a, c); return sum32(a + c); }
__device__ __forceinline__ float wave_max(float v) { v = fmaxf(v, dppf<0xB1>(v)); v = fmaxf(v, dppf<0x4E>(v)); v = fmaxf(v, dppf<0x141>(v)); v = fmaxf(v, dppf<0x140>(v)); float a, c; halves16(v, a, c); return max32(fmaxf(a, c)); }
constexpr float SY8 = 8.0f;
__device__ __forceinline__ u32x2 pack8_fp8(const float (&v)[8], float s) { float t[8];
#pragma unroll
    for (int k = 0; k < 8; ++k) t[k] = __builtin_amdgcn_fmed3f(v[k] * s, -448.0f, 448.0f);
    int w0 = 0, w1 = 0; w0 = __builtin_amdgcn_cvt_pk_fp8_f32(t[0], t[1], w0, false); w0 = __builtin_amdgcn_cvt_pk_fp8_f32(t[2], t[3], w0, true); w1 = __builtin_amdgcn_cvt_pk_fp8_f32(t[4], t[5], w1, false); w1 = __builtin_amdgcn_cvt_pk_fp8_f32(t[6], t[7], w1, true);
    return (u32x2){(unsigned)w0, (unsigned)w1}; }
__device__ __forceinline__ void unpack8(u32x4 w, float (&v)[8]) {
    v[0] = bf2f(w.x & 0xffff); v[1] = bf2f(w.x >> 16); v[2] = bf2f(w.y & 0xffff); v[3] = bf2f(w.y >> 16);
    v[4] = bf2f(w.z & 0xffff); v[5] = bf2f(w.z >> 16); v[6] = bf2f(w.w & 0xffff); v[7] = bf2f(w.w >> 16);
}
__device__ __forceinline__ u32x4 pack8(const float (&v)[8]) { u32x4 w; w.x = pk2(v[0], v[1]); w.y = pk2(v[2], v[3]); w.z = pk2(v[4], v[5]); w.w = pk2(v[6], v[7]); return w; }

struct NormArgs { const float* XL; const float* XC; const bf16* XB; const float* MODl; int jA, jS; bf16* H; int nrows;
                  const float* rw; const float* rb; unsigned* cnt; int* list; float* glist; float* rs8; float* rsl; const bf16* y1; bf16* WB; };
__device__ __forceinline__ float write_row_i8(const f32x4 (&v)[4], signed char* H8row, float* rs, int lane) {
    float am = 0.f;
#pragma unroll
    for (int j = 0; j < 4; ++j) am = fmaxf(fmaxf(am, fmaxf(fabsf(v[j].x), fabsf(v[j].y))), fmaxf(fabsf(v[j].z), fabsf(v[j].w)));
    am = wave_max(am);
    const float isc = am > 0.f ? 127.0f / am : 0.f; if (lane == 0) *rs = am * (1.0f / 127.0f);
#pragma unroll
    for (int j = 0; j < 4; ++j) { const int a = (int)rintf(v[j].x * isc), b = (int)rintf(v[j].y * isc), c = (int)rintf(v[j].z * isc), e = (int)rintf(v[j].w * isc);
        ((unsigned*)H8row)[lane + 64 * j] = (unsigned)(a & 255) | ((unsigned)(b & 255) << 8) | ((unsigned)(c & 255) << 16) | ((unsigned)(e & 255) << 24); }
    return am * (1.0f / 127.0f);
}
struct NormRow { f32x4 v[4]; u32x2 xb[4]; u32x2 y[4]; f32x4 av[4], sv[4]; };
__device__ __forceinline__ void unpack4(u32x2 w, f32x4& v) { v.x = bf2f(w.x & 0xffff); v.y = bf2f(w.x >> 16); v.z = bf2f(w.y & 0xffff); v.w = bf2f(w.y >> 16); }
__device__ __forceinline__ void norm_load(const NormArgs& a, int row, int lane, NormRow& r) {
    if (a.XB) { const u32x2* xr = (const u32x2*)(a.XB + (size_t)row * D);
#pragma unroll
        for (int j = 0; j < 4; ++j) r.xb[j] = xr[lane + 64 * j]; }
    else { const float* xr = row < ML ? a.XL + (size_t)row * D : a.XC + (size_t)(row - ML) * D;
#pragma unroll
        for (int j = 0; j < 4; ++j) r.v[j] = *(const f32x4*)(xr + 4 * lane + 256 * j); }
    if (a.y1) { const u32x2* yr = (const u32x2*)(a.y1 + (size_t)row * D);
#pragma unroll
        for (int j = 0; j < 4; ++j) r.y[j] = yr[lane + 64 * j]; }
    { const int b = row < ML ? row >> 11 : 16; const float* A = a.MODl + ((size_t)b * 6 + a.jA) * 1024; const float* S = a.MODl + ((size_t)b * 6 + a.jS) * 1024;
#pragma unroll
      for (int j = 0; j < 4; ++j) { r.av[j] = *(const f32x4*)(A + 4 * lane + 256 * j); r.sv[j] = *(const f32x4*)(S + 4 * lane + 256 * j); } }
}
__device__ __forceinline__ void norm_finish(const NormArgs& a, int row, int lane, NormRow& r) {
    f32x4 (&v)[4] = r.v; float ss = 0.f;
    if (a.XB) {
#pragma unroll
        for (int j = 0; j < 4; ++j) unpack4(r.xb[j], v[j]); }
    if (a.y1) { u32x2* xw = (u32x2*)(a.WB + (size_t)row * D);
#pragma unroll
        for (int j = 0; j < 4; ++j) { f32x4 y; unpack4(r.y[j], y); v[j] = v[j] + y; u32x2 w; w.x = pk2(v[j].x, v[j].y); w.y = pk2(v[j].z, v[j].w); xw[lane + 64 * j] = w; unpack4(w, v[j]); } }
#pragma unroll
    for (int j = 0; j < 4; ++j) ss += (v[j].x * v[j].x + v[j].y * v[j].y) + (v[j].z * v[j].z + v[j].w * v[j].w);
    const float rstd = rsqrtf(wave_sum(ss) * (1.0f / D) + EPS);
#pragma unroll
    for (int j = 0; j < 4; ++j) v[j] = v[j] * rstd * r.av[j] + r.sv[j];
    if (a.rs8) { write_row_i8(v, (signed char*)a.H + (size_t)row * D, a.rs8 + row, lane); return; }
    u32x2* o = (u32x2*)(a.H + (size_t)row * D);
#pragma unroll
    for (int j = 0; j < 4; ++j) { u32x2 w; w.x = pk2(v[j].x, v[j].y); w.y = pk2(v[j].z, v[j].w); o[lane + 64 * j] = w; }
}
__device__ __forceinline__ void norm_rows(const NormArgs& a, int r0, int n, int lane) {
    NormRow ra, rb; norm_load(a, r0, lane, ra);
    for (int i = 0; i < n; i += 2) {
        norm_load(a, r0 + i + 1, lane, rb); norm_finish(a, r0 + i, lane, ra);
        if (i + 2 < n) norm_load(a, r0 + i + 2, lane, ra);
        norm_finish(a, r0 + i + 1, lane, rb); }
}
constexpr size_t WS_WIN = 9 * MiB, WS_WOUT = 27 * MiB, WS_DUP = 35 * MiB, WS_DDN = 46 * MiB, WS_MUP = 57 * MiB, WS_MDN = 145 * MiB;
static_assert(WS_MDN + 88 * MiB <= WS_XB && WS_XB + 72 * MiB <= WS_H && WS_MOE + 2 * MOE_GATE <= WS_WIN && WS_RSL + 3 * MiB <= WS_P && WS_H + 72 * MiB <= WS_RSL && WS_P + 418 * MiB <= WS_END, "ws map");
constexpr int NUP = 2 * DFF;
constexpr int CW_BAR = 4096;

#define LAS __attribute__((address_space(3)))
#define GAS __attribute__((address_space(1)))
typedef short bf16x8 __attribute__((ext_vector_type(8)));
typedef GAS unsigned gu32;
#define RLX_AGENT __ATOMIC_RELAXED, __HIP_MEMORY_SCOPE_AGENT

namespace pg8 {
constexpr int BM = 256, BK = 64, HALF = 128, HTB = HALF * BK * 2, STAGE_BYTES = 8 * HTB, NXCD = 8, WGM = 8;
__host__ __device__ __forceinline__ int lds_byte(int r, int c) { const int st = (r >> 4) * 2 + (c >> 5), rr = r & 15, cc = c & 31, ob = rr * 64 + cc * 2; return st * 1024 + (ob ^ (((ob >> 9) & 1) << 5)); }
__host__ __device__ __forceinline__ void stage_rc(int b, int& R, int& C) { const int st = b / 1024, sb = b % 1024, swz = sb ^ (((sb >> 9) & 1) << 5); R = (st >> 1) * 16 + swz / 64; C = (st & 1) * 32 + (swz % 64) / 2; }
__host__ __device__ __forceinline__ int perm32(int rho) { const int n = rho >> 4, i = rho & 15; return 8 * (i >> 2) + 4 * n + (i & 3); }

struct Unit { int pm, pn, e, row0, nval; };

__device__ __forceinline__ bool order_unit(long L, int nM, int nN, int& pm, int& pn) {
    const int nwg = nM * nN; if (L >= nwg) return false;
    int wgid = (int)L; { const int q = nwg / NXCD, r = nwg % NXCD, xcd = wgid % NXCD, off = wgid / NXCD; wgid = (xcd < r ? xcd * (q + 1) : r * (q + 1) + (xcd - r) * q) + off; }
    const int nig = WGM * nN, gid = wgid / nig, fm = gid * WGM, gsz = (nM - fm) < WGM ? (nM - fm) : WGM;
    pm = fm + ((wgid % nig) % gsz); pn = (wgid % nig) / gsz; return true;
}
__device__ __forceinline__ bool order_next(int i, int nM, int nN, int G, int c, int& pm, int& pn) { return order_unit((long)i * G + c, nM, nN, pm, pn); }
struct DenseSched {
    static constexpr bool GATHER = false;
    const char* A; const char* Bt; int K, nM, nN, G, c;
    __device__ __forceinline__ bool next(int i, Unit& u) const { u.e = 0; u.row0 = 0; u.nval = 256; return order_next(i, nM, nN, G, c, u.pm, u.pn); }
    __device__ __forceinline__ const char* a_tile(const Unit& u) const { return A + (size_t)u.pm * 256 * K * 2; }
    __device__ __forceinline__ const char* b_tile(const Unit& u) const { return Bt + (size_t)u.pn * 256 * K * 2; }
    __device__ __forceinline__ unsigned arow_off(const Unit&, int r) const { return (unsigned)(r * K * 2); }
};
struct InprojSched {
    static constexpr bool GATHER = false;
    const char* A; const char* Bt; int K, nM, nN, G, c; bool lastl;
    __device__ __forceinline__ bool next(int i, Unit& u) const { u.e = 0; u.row0 = 0; u.nval = 256;
        if (!lastl) return order_next(i, nM, nN, G, c, u.pm, u.pn);
        const long L = (long)i * G + c; constexpr int NLAT = (ML / 256) * (NIN / 256);
        if (L < NLAT) return order_unit(L, ML / 256, NIN / 256, u.pm, u.pn);
        const int idx = (int)(L - NLAT); if (idx >= 3 * (MC / 256)) return false;
        const int r = idx % 3; u.pm = ML / 256 + idx / 3; u.pn = r == 0 ? 2 : 6 + r; return true; }
    __device__ __forceinline__ const char* a_tile(const Unit& u) const { return A + (size_t)u.pm * 256 * K * 2; }
    __device__ __forceinline__ const char* b_tile(const Unit& u) const { return Bt + (size_t)u.pn * 256 * K * 2; }
    __device__ __forceinline__ unsigned arow_off(const Unit&, int r) const { return (unsigned)(r * K * 2); }
};
template <bool GATH> struct MoeSched {
    static constexpr bool GATHER = GATH;
    const char* A; const char* Bt; size_t estride; int K, nN, G, c; const int* list; int cn[16];
    __device__ __forceinline__ void init_counts(const unsigned* cnt) {
#pragma unroll
        for (int j = 0; j < 16; ++j) cn[j] = (int)cnt[j]; }
    __device__ __forceinline__ bool next(int i, Unit& u) const {
        int tot = 0;
#pragma unroll
        for (int j = 0; j < 16; ++j) tot += (cn[j] + 255) >> 8;
        int vp, pn; if (!order_next(i, tot, nN, G, c, vp, pn)) return false;
        int e = 0, pb = 0, ce = cn[0], p = (cn[0] + 255) >> 8;
#pragma unroll
        for (int j = 1; j < 16; ++j) { if (vp >= p) { e = j; pb = p; ce = cn[j]; } p += (cn[j] + 255) >> 8; }
        u.pm = vp; u.pn = pn; u.e = e; u.row0 = 256 * (vp - pb); u.nval = ce - u.row0; return true;
    }
    __device__ __forceinline__ const char* a_tile(const Unit& u) const { return GATH ? A : A + (size_t)u.pm * 256 * K * 2; }
    __device__ __forceinline__ const char* b_tile(const Unit& u) const { return Bt + (size_t)(u.e & 7) * estride + (size_t)u.pn * 256 * K * 2; }
    __device__ __forceinline__ unsigned arow_off(const Unit& u, int r) const {
        if constexpr (GATH) { const int rr = r < u.nval ? r : u.nval - 1; return (unsigned)list[(size_t)u.e * MT + u.row0 + rr] * (unsigned)(K * 2); }
        else return (unsigned)(r * K * 2);
    }
};

typedef int i32x4 __attribute__((ext_vector_type(4))); typedef int i32x8 __attribute__((ext_vector_type(8)));
template <bool I8> struct AccT { typedef f32x4 type; }; template <> struct AccT<true> { typedef i32x4 type; };
__device__ __forceinline__ f32x4 acc_f32(const f32x4& a) { return a; }
__device__ __forceinline__ f32x4 acc_f32(const i32x4& a) { return (f32x4){(float)a[0], (float)a[1], (float)a[2], (float)a[3]}; }
typedef float f32x2_e __attribute__((ext_vector_type(2))); typedef __bf16 bf16x2_e __attribute__((ext_vector_type(2)));
__device__ __forceinline__ unsigned cvt_pk_bf16(float lo, float hi) { const f32x2_e v = {lo, hi}; const bf16x2_e b = __builtin_convertvector(v, bf16x2_e); return __builtin_bit_cast(unsigned, b); }
template <bool I8_> struct EpiInprojT {
    static constexpr bool PERM = true, I8 = I8_, F8 = false; typedef typename AccT<I8_>::type acc_t;
    bf16* O; const float* TAB; const float* aqg; const float* akg; const float* dqg; const float* dkg; const float* rs; const unsigned* cmax;
    __device__ __forceinline__ void operator()(acc_t (&acc)[2][2][4][2], const Unit& u, int wr, int wc, int fr_, int fq_) const {
        int fr = fr_, fq = fq_; asm volatile("" : "+v"(fr), "+v"(fq));
        const int pn = u.pn; const bool lat = u.pm < ML / BM; const int row0 = u.pm * BM + wr * 64 + fr;
        if constexpr (I8_) {
            float rsv[2][4];
#pragma unroll
            for (int ai = 0; ai < 2; ++ai)
#pragma unroll
                for (int m = 0; m < 4; ++m) rsv[ai][m] = rs[row0 + ai * HALF + m * 16];
#pragma unroll
            for (int bj = 0; bj < 2; ++bj)
#pragma unroll
                for (int n = 0; n < 2; ++n) { const u32x4 a = *(const u32x4*)(cmax + 256 * pn + HALF * bj + 32 * wc + 8 * fq + 4 * n); const f32x4 csv = (f32x4){__uint_as_float(a.x), __uint_as_float(a.y), __uint_as_float(a.z), __uint_as_float(a.w)} * (1.0f / 127.0f);
#pragma unroll
                    for (int ai = 0; ai < 2; ++ai)
#pragma unroll
                        for (int m = 0; m < 4; ++m) acc[ai][bj][m][n] = __builtin_bit_cast(acc_t, acc_f32(acc[ai][bj][m][n]) * (csv * rsv[ai][m])); }
        }
#define XV(ai, bj, m, n) __builtin_bit_cast(f32x4, acc[ai][bj][m][n])
        if (pn < 3 && !(pn == 2 && wc >= 2)) {
            const float* gp = (pn < 2 ? aqg : akg) + 8 * fq; const float sc = pn < 2 ? C2A : 1.0f; const int f0 = 8 * (fq & 1); const bool isx2 = fq >= 2;
            f32x4 g[2][2];
#pragma unroll
            for (int bj = 0; bj < 2; ++bj)
#pragma unroll
                for (int n = 0; n < 2; ++n) g[bj][n] = *(const f32x4*)(gp + 32 * bj + 4 * n);
            f32x4 cr[2][2], sr[2][2];
#pragma unroll
            for (int ai = 0; ai < 2; ++ai) { const int prow = lat ? (4 * u.pm + 2 * ai + wr) & 31 : 0;
#pragma unroll
                for (int n = 0; n < 2; ++n) { cr[ai][n] = *(const f32x4*)(TAB + TB_COSA + prow * 16 + f0 + 4 * n); sr[ai][n] = *(const f32x4*)(TAB + TB_SINA + prow * 16 + f0 + 4 * n); } }
            const float csc = sc, ssc = isx2 ? sc : -sc;
            const int paddr = ((((fq ^ 2) << 4) | fr) << 2);
#pragma unroll
            for (int ai = 0; ai < 2; ++ai)
#pragma unroll
                for (int n = 0; n < 2; ++n) { cr[ai][n] = cr[ai][n] * csc; sr[ai][n] = sr[ai][n] * ssc; }
#pragma unroll
            for (int mh = 0; mh < 4; ++mh) { f32x4 cc[1][2], sn[1][2];
#pragma unroll
                for (int mi = 0; mi < 1; ++mi) { const int pcol = lat ? 16 * (mh + mi) + fr : 0;
#pragma unroll
                    for (int n = 0; n < 2; ++n) { cc[mi][n] = *(const f32x4*)(TAB + TB_COSA + pcol * 16 + f0 + 4 * n) * csc; sn[mi][n] = *(const f32x4*)(TAB + TB_SINA + pcol * 16 + f0 + 4 * n) * ssc; } }
#pragma unroll
                for (int mi = 0; mi < 1; ++mi)
#pragma unroll
                    for (int ai = 0; ai < 2; ++ai) { const int m = mh + mi;
                    float ss = 0.f;
#pragma unroll
                    for (int bj = 0; bj < 2; ++bj)
#pragma unroll
                        for (int n = 0; n < 2; ++n) { const f32x4 x = XV(ai, bj, m, n); ss += (x[0] * x[0] + x[1] * x[1]) + (x[2] * x[2] + x[3] * x[3]); }
                    ss += shx<16>(ss); ss = sum32(ss);
                    const float rstd = rsqrtf(ss * (1.0f / 64.0f) + EPS);
                    bf16* rowp = O + (size_t)(row0 + ai * HALF + m * 16) * NIN + 256 * pn + 64 * wc + 8 * fq;
#pragma unroll
                    for (int bj = 0; bj < 2; ++bj) { float o[8];
#pragma unroll
                        for (int n = 0; n < 2; ++n) { const f32x4 xq = XV(ai, bj, m, n) * (g[bj][n] * rstd);
#pragma unroll
                            for (int e = 0; e < 4; ++e) { const float xv = xq[e]; const float p = __builtin_bit_cast(float, __builtin_amdgcn_ds_bpermute(paddr, __builtin_bit_cast(int, xv)));
                                const float cs_ = bj ? cc[mi][n][e] : cr[ai][n][e], sv = bj ? sn[mi][n][e] : sr[ai][n][e];
                                o[4 * n + e] = xv * cs_ + p * sv; } }
                        u32x4 w; w.x = cvt_pk_bf16(o[0], o[1]); w.y = cvt_pk_bf16(o[2], o[3]); w.z = cvt_pk_bf16(o[4], o[5]); w.w = cvt_pk_bf16(o[6], o[7]);
                        *(u32x4*)(rowp + 32 * bj) = w; } } }
        } else if (pn == 6 || pn == 7) {
            const float* gp = (pn == 6 ? dqg : dkg) + 8 * fq; const float sc = pn == 6 ? C2C : 1.0f; const bool isx2 = (fq & 1) != 0;
            f32x4 g[2];
#pragma unroll
            for (int n = 0; n < 2; ++n) g[n] = *(const f32x4*)(gp + 4 * n);
            const float csc = sc, ssc = isx2 ? sc : -sc;
#pragma unroll
            for (int mh = 0; mh < 4; ++mh) { f32x4 cs2[1][2][2], sv[1][2][2];
#pragma unroll
                for (int mi = 0; mi < 1; ++mi)
#pragma unroll
                    for (int ai = 0; ai < 2; ++ai) { const int prow = (4 * u.pm + 2 * ai + wr) & 31; const int pos = lat ? (fq >= 2 ? 16 * (mh + mi) + fr : prow) : 0;
#pragma unroll
                        for (int n = 0; n < 2; ++n) { cs2[mi][ai][n] = *(const f32x4*)(TAB + TB_COSC + pos * 8 + 4 * n) * csc; sv[mi][ai][n] = *(const f32x4*)(TAB + TB_SINC + pos * 8 + 4 * n) * ssc; } }
#pragma unroll
                for (int mi = 0; mi < 1; ++mi)
#pragma unroll
                    for (int ai = 0; ai < 2; ++ai) { const int m = mh + mi;
                    bf16* rowp = O + (size_t)(row0 + ai * HALF + m * 16) * NIN + 256 * pn + 32 * wc + 8 * fq;
#pragma unroll
                    for (int bj = 0; bj < 2; ++bj) { float ss = 0.f;
#pragma unroll
                        for (int n = 0; n < 2; ++n) { const f32x4 x = XV(ai, bj, m, n); ss += (x[0] * x[0] + x[1] * x[1]) + (x[2] * x[2] + x[3] * x[3]); }
                        ss += shx<16>(ss); ss = sum32(ss);
                        const float rstd = rsqrtf(ss * (1.0f / 32.0f) + EPS); float o[8];
#pragma unroll
                        for (int n = 0; n < 2; ++n) { const f32x4 xq = XV(ai, bj, m, n) * (g[n] * rstd);
#pragma unroll
                            for (int e = 0; e < 4; ++e) { const float xv = xq[e]; const float p = shx<16>(xv);
                                o[4 * n + e] = xv * cs2[mi][ai][n][e] + p * sv[mi][ai][n][e]; } }
                        u32x4 w; w.x = cvt_pk_bf16(o[0], o[1]); w.y = cvt_pk_bf16(o[2], o[3]); w.z = cvt_pk_bf16(o[4], o[5]); w.w = cvt_pk_bf16(o[6], o[7]);
                        *(u32x4*)(rowp + HALF * bj) = w; } } }
        } else {
            const int colb = pn < 3 ? 256 * pn + 64 * wc + 8 * fq : 256 * pn + 32 * wc + 8 * fq; const int bjs = pn < 3 ? 32 : HALF;
#pragma unroll
            for (int ai = 0; ai < 2; ++ai)
#pragma unroll
                for (int m = 0; m < 4; ++m) { bf16* rowp = O + (size_t)(row0 + ai * HALF + m * 16) * NIN + colb;
#pragma unroll
                    for (int bj = 0; bj < 2; ++bj) { const f32x4 v0 = XV(ai, bj, m, 0), v1 = XV(ai, bj, m, 1); u32x4 w; w.x = cvt_pk_bf16(v0[0], v0[1]); w.y = cvt_pk_bf16(v0[2], v0[3]); w.z = cvt_pk_bf16(v1[0], v1[1]); w.w = cvt_pk_bf16(v1[2], v1[3]);
                        *(u32x4*)(rowp + bjs * bj) = w; } }
        }
#undef XV
    }
};
__device__ __forceinline__ float silu_mul(float g, float u) { return g * __builtin_amdgcn_rcpf(1.0f + __builtin_amdgcn_exp2f(-LOG2E * g)) * u; }
struct EpiSwigluI8 {
    static constexpr bool PERM = true, I8 = true, F8 = false; unsigned char* O; int ldc; const float* rs; const unsigned* cmax0; int cstride; bool gath; const float* f8tab; int set0;
    __device__ __forceinline__ void operator()(const i32x4 (&acc)[2][2][4][2], const Unit& u, int wr, int wc, int fr, int fq) const {
        const int row0 = u.pm * BM + wr * 64 + fr, col0 = u.pn * HALF + wc * 32 + 8 * fq, brow0 = u.pn * BM + wc * 32 + 8 * fq; const unsigned* cmax = cmax0 + (u.e & 7) * cstride;
        const float sa = f8tab[4 * (set0 + (gath ? (u.e & 7) : 0)) + 1];
        f32x4 cA[2], cB[2];
#pragma unroll
        for (int n = 0; n < 2; ++n) { const u32x4 a = *(const u32x4*)(cmax + brow0 + 4 * n), b = *(const u32x4*)(cmax + brow0 + HALF + 4 * n);
            const f32x4 cg = (f32x4){__uint_as_float(a.x), __uint_as_float(a.y), __uint_as_float(a.z), __uint_as_float(a.w)} * (1.0f / 127.0f), cu = (f32x4){__uint_as_float(b.x), __uint_as_float(b.y), __uint_as_float(b.z), __uint_as_float(b.w)} * (1.0f / 127.0f);
            cA[n] = cg * (-LOG2E); cB[n] = cg * cu * sa; }
        float rsa[2][4];
#pragma unroll
        for (int ai = 0; ai < 2; ++ai)
#pragma unroll
            for (int m = 0; m < 4; ++m) { const int rr = ai * HALF + wr * 64 + m * 16 + fr; if (gath) { const int r2 = rr < u.nval ? rr : u.nval - 1; rsa[ai][m] = rs[(size_t)u.e * MT + u.row0 + r2]; } else rsa[ai][m] = rs[u.pm * BM + rr]; }
#pragma unroll
        for (int ai = 0; ai < 2; ++ai)
#pragma unroll
            for (int m = 0; m < 4; ++m) { unsigned char* rowp = O + (size_t)(row0 + ai * HALF + m * 16) * ldc + col0; const float rsv = rsa[ai][m], rs2 = rsv * rsv;
                f32x4 o[2];
#pragma unroll
                for (int n = 0; n < 2; ++n)
#pragma unroll
                    for (int h = 0; h < 2; ++h) { typedef float f32x2 __attribute__((ext_vector_type(2)));
                        const f32x2 G = {(float)acc[ai][0][m][n][2 * h], (float)acc[ai][0][m][n][2 * h + 1]}, U = {(float)acc[ai][1][m][n][2 * h], (float)acc[ai][1][m][n][2 * h + 1]};
                        const f32x2 ca = {cA[n][2 * h], cA[n][2 * h + 1]}, cb = {cB[n][2 * h], cB[n][2 * h + 1]};
                        const f32x2 t = G * (ca * rsv); const f32x2 d = (f32x2){__builtin_amdgcn_exp2f(t[0]), __builtin_amdgcn_exp2f(t[1])} + 1.0f;
                        const f32x2 r = {__builtin_amdgcn_rcpf(d[0]), __builtin_amdgcn_rcpf(d[1])};
                        const f32x2 x = (G * U) * (cb * rs2) * r;
                        o[n][2 * h] = __builtin_amdgcn_fmed3f(x[0], -448.0f, 448.0f); o[n][2 * h + 1] = __builtin_amdgcn_fmed3f(x[1], -448.0f, 448.0f); }
                int w0 = 0, w1 = 0; w0 = __builtin_amdgcn_cvt_pk_fp8_f32(o[0][0], o[0][1], w0, false); w0 = __builtin_amdgcn_cvt_pk_fp8_f32(o[0][2], o[0][3], w0, true); w1 = __builtin_amdgcn_cvt_pk_fp8_f32(o[1][0], o[1][1], w1, false); w1 = __builtin_amdgcn_cvt_pk_fp8_f32(o[1][2], o[1][3], w1, true);
                *(u32x2*)rowp = (u32x2){(unsigned)w0, (unsigned)w1}; }
    }
};
__device__ __forceinline__ void unpack8f(u32x4 w, f32x4& lo, f32x4& hi) { lo = (f32x4){bf2f(w.x & 0xffff), bf2f(w.x >> 16), bf2f(w.y & 0xffff), bf2f(w.y >> 16)}; hi = (f32x4){bf2f(w.z & 0xffff), bf2f(w.z >> 16), bf2f(w.w & 0xffff), bf2f(w.w >> 16)}; }
__device__ __forceinline__ u32x4 pack8f(f32x4 lo, f32x4 hi) { u32x4 w; w.x = cvt_pk_bf16(lo[0], lo[1]); w.y = cvt_pk_bf16(lo[2], lo[3]); w.z = cvt_pk_bf16(hi[0], hi[1]); w.w = cvt_pk_bf16(hi[2], hi[3]); return w; }
template <bool F8_> struct EpiResT {
    static constexpr bool PERM = true, I8 = false, F8 = F8_; const float* baseL; const float* baseC; bf16* XB; const float* MODl; int jG; float dq;
    __device__ __forceinline__ void operator()(const f32x4 (&acc)[2][2][4][2], const Unit& u, int wr, int wc, int fr, int fq) const {
        if constexpr (F8_) { const int t_ = lane_now(); fr = t_ & 15; fq = t_ >> 4; }
        const bool lat = u.pm < ML / BM; const int b = lat ? u.pm >> 3 : 16; const int row0 = u.pm * BM + wr * 64 + fr, col0 = u.pn * BM + wc * 32 + 8 * fq;
        const float* gp = MODl + ((size_t)b * 6 + jG) * 1024 + col0; f32x4 gt[2][2];
#pragma unroll
        for (int bj = 0; bj < 2; ++bj)
#pragma unroll
            for (int n = 0; n < 2; ++n) gt[bj][n] = *(const f32x4*)(gp + bj * HALF + 4 * n) * dq;
        if (baseL) {
            const float* bp = lat ? baseL + (size_t)row0 * D + col0 : baseC + (size_t)(row0 - ML) * D + col0;
#pragma unroll
            for (int ai = 0; ai < 2; ++ai) { f32x4 bs[4][2][2];
#pragma unroll
                for (int m = 0; m < 4; ++m)
#pragma unroll
                    for (int bj = 0; bj < 2; ++bj)
#pragma unroll
                        for (int n = 0; n < 2; ++n) bs[m][bj][n] = *(const f32x4*)(bp + (size_t)(ai * HALF + m * 16) * D + bj * HALF + 4 * n);
#pragma unroll
                for (int m = 0; m < 4; ++m)
#pragma unroll
                    for (int bj = 0; bj < 2; ++bj) *(u32x4*)(XB + (size_t)(row0 + ai * HALF + m * 16) * D + col0 + bj * HALF) = pack8f(bs[m][bj][0] + gt[bj][0] * acc[ai][bj][m][0], bs[m][bj][1] + gt[bj][1] * acc[ai][bj][m][1]);
                asm volatile("" ::: "memory"); }
        } else {
            u32x4 bs[2][4][2];
#pragma unroll
            for (int ai = 0; ai < 2; ++ai)
#pragma unroll
                for (int m = 0; m < 4; ++m)
#pragma unroll
                    for (int bj = 0; bj < 2; ++bj) bs[ai][m][bj] = *(const u32x4*)(XB + (size_t)(row0 + ai * HALF + m * 16) * D + col0 + bj * HALF);
#pragma unroll
            for (int ai = 0; ai < 2; ++ai)
#pragma unroll
                for (int m = 0; m < 4; ++m)
#pragma unroll
                    for (int bj = 0; bj < 2; ++bj) { f32x4 lo, hi; unpack8f(bs[ai][m][bj], lo, hi);
                        *(u32x4*)(XB + (size_t)(row0 + ai * HALF + m * 16) * D + col0 + bj * HALF) = pack8f(lo + gt[bj][0] * acc[ai][bj][m][0], hi + gt[bj][1] * acc[ai][bj][m][1]); }
        }
    }
};
struct EpiMoeDown {
    static constexpr bool PERM = true, I8 = false, F8 = true; bf16* XB; const float* MODl; int jG; const int* list; const float* glist; bf16* Y1; const float* f8tab; int set0;
    __device__ __forceinline__ void operator()(const f32x4 (&acc)[2][2][4][2], const Unit& u, int wr, int wc, int fr, int fq) const {
        { const int t_ = lane_now(); fr = t_ & 15; fq = t_ >> 4; }
        const int col0 = u.pn * BM + wc * 32 + 8 * fq; const bool r1 = u.e >= 8; const float dq = f8tab[4 * (set0 + (u.e & 7)) + 2];
        int tok[2][4]; float gw[2][4];
#pragma unroll
        for (int ai = 0; ai < 2; ++ai)
#pragma unroll
            for (int m = 0; m < 4; ++m) { const int rr = ai * HALF + wr * 64 + m * 16 + fr; const bool ok = rr < u.nval; const size_t li = (size_t)u.e * MT + u.row0 + (ok ? rr : 0);
                tok[ai][m] = ok ? list[li] : -1; gw[ai][m] = glist[li] * dq; }
#pragma unroll
        for (int ai = 0; ai < 2; ++ai) { u32x4 bs[4][2];
#pragma unroll
            for (int m = 0; m < 4; ++m) { const int tk = tok[ai][m]; const int tq = tk >= 0 ? tk : 0;
#pragma unroll
                for (int bj = 0; bj < 2; ++bj) bs[m][bj] = r1 ? (u32x4){0, 0, 0, 0} : *(const u32x4*)(XB + (size_t)tq * D + col0 + bj * HALF); }
#pragma unroll
            for (int m = 0; m < 4; ++m) { const int tk = tok[ai][m];
                if (tk >= 0) { const int b = tk < ML ? tk >> 11 : 16; const float g = gw[ai][m]; const float* gp = MODl + ((size_t)b * 6 + jG) * 1024 + col0; bf16* op = (r1 ? Y1 : XB) + (size_t)tk * D + col0;
#pragma unroll
                    for (int bj = 0; bj < 2; ++bj) { const f32x4 g0 = *(const f32x4*)(gp + bj * HALF), g1 = *(const f32x4*)(gp + bj * HALF + 4); f32x4 lo, hi; unpack8f(bs[m][bj], lo, hi);
                        *(u32x4*)(op + bj * HALF) = pack8f(lo + g0 * g * acc[ai][bj][m][0], hi + g1 * g * acc[ai][bj][m][1]); } } }
            asm volatile("" ::: "memory"); }
    }
};

template <class Epi, class Sched, bool ALIGN_EPI>
__device__ __forceinline__ void gemm_phase(LAS unsigned char* lds, const Sched& S, const Epi& E, int wv) {
    const int tid_ = wv * 64 + lane_now();
    const int tid = tid_, wid = __builtin_amdgcn_readfirstlane(tid >> 6), lane = tid & 63, wr = wid >> 2, wc = wid & 3, fr = lane & 15, fq = lane >> 4;
    const int K = S.K, nt = K / BK;
    unsigned voffB[2];
#pragma unroll
    for (int i = 0; i < 2; ++i) { int R, C; stage_rc(tid * 16 + i * 8192, R, C); const int Rb = Epi::PERM ? ((R & ~31) + perm32(R & 31)) : R; voffB[i] = (unsigned)(Rb * K + C) * 2u; }
    const size_t kstep = (size_t)(BK * 2);
    const size_t hstep = (size_t)HALF * K * 2;
    const unsigned ldsw = (unsigned)wid * 1024u;
    const int aoff = lds_byte(wr * 64 + fr, fq * 8), boff = lds_byte(wc * 32 + fr, fq * 8);
#define PG8_SA(b, h) (((b) * 2 + (h)) * HTB)
#define PG8_SB(b, h) ((4 + (b) * 2 + (h)) * HTB)
#define PG8_STAGE(bufoff, gbase, voff) do { _Pragma("unroll") for (int _i = 0; _i < 2; ++_i) \
        __builtin_amdgcn_global_load_lds((const unsigned*)((const char*)(gbase) + (voff)[_i]), (LAS unsigned*)(lds + (bufoff) + ldsw + _i * 8192), 16, 0, 0); } while (0)
#define PG8_STAGE_A1(bufoff, gbase, va) do { if constexpr (Epi::F8) PG8_STAGE(bufoff, (gbase) + hstep, (va)[0]); else PG8_STAGE(bufoff, gbase, (va)[1]); } while (0)
#define PG8_LDA(dst, b, h) do { if constexpr (Epi::F8) { _Pragma("unroll") for (int m = 0; m < 4; ++m) dst##8[m] = PG8_CAT8(*(const LAS bf16x8*)(lds + PG8_SA(b, h) + aoff + m * 2048), *(const LAS bf16x8*)(lds + PG8_SA(b, h) + aoff + m * 2048 + 1024)); } \
        else { _Pragma("unroll") for (int m = 0; m < 4; ++m) _Pragma("unroll") for (int k = 0; k < 2; ++k) dst[m][k] = *(const LAS bf16x8*)(lds + PG8_SA(b, h) + aoff + m * 2048 + k * 1024); } } while (0)
#define PG8_LDB(dst, b, h) do { if constexpr (Epi::F8) { _Pragma("unroll") for (int n = 0; n < 2; ++n) dst##8[n] = PG8_CAT8(*(const LAS bf16x8*)(lds + PG8_SB(b, h) + boff + n * 2048), *(const LAS bf16x8*)(lds + PG8_SB(b, h) + boff + n * 2048 + 1024)); } \
        else { _Pragma("unroll") for (int n = 0; n < 2; ++n) _Pragma("unroll") for (int k = 0; k < 2; ++k) dst[n][k] = *(const LAS bf16x8*)(lds + PG8_SB(b, h) + boff + n * 2048 + k * 1024); } } while (0)
#define PG8_MMA(ai, bj, At, Bt) do { __builtin_amdgcn_s_setprio(1); _Pragma("unroll") for (int m = 0; m < 4; ++m) _Pragma("unroll") for (int n = 0; n < 2; ++n) _Pragma("unroll") for (int k = 0; k < 2; ++k) \
        { if constexpr (Epi::F8) { if (k == 0) asm volatile("v_mfma_f32_16x16x128_f8f6f4 %0, %1, %2, %0" : "+v"(acc[ai][bj][m][n]) : "v"(Bt##8[n]), "v"(At##8[m])); }   \
          else if constexpr (Epi::I8) acc[ai][bj][m][n] = __builtin_amdgcn_mfma_i32_16x16x64_i8(__builtin_bit_cast(i32x4, Bt[n][k]), __builtin_bit_cast(i32x4, At[m][k]), acc[ai][bj][m][n], 0, 0, 0); \
          else acc[ai][bj][m][n] = __builtin_amdgcn_mfma_f32_16x16x32_bf16(Bt[n][k], At[m][k], acc[ai][bj][m][n], 0, 0, 0); } __builtin_amdgcn_s_setprio(0); } while (0)
#define PG8_CAT8(lo, hi) __builtin_shufflevector(__builtin_bit_cast(i32x4, lo), __builtin_bit_cast(i32x4, hi), 0, 1, 2, 3, 4, 5, 6, 7)
#define PG8_WAIT_V(n) asm volatile("s_waitcnt vmcnt(" #n ")" ::: "memory")
#define PG8_WAIT_L(n) asm volatile("s_waitcnt lgkmcnt(" #n ")" ::: "memory")
#define PG8_BAR __builtin_amdgcn_s_barrier()
#define PG8_SCHED __builtin_amdgcn_sched_barrier(0)
#define PG8_SETVA(va, u) do { int _t = tid; asm volatile("" : "+v"(_t));     \
        _Pragma("unroll") for (int _i = 0; _i < 2; ++_i) { int _R, _C; stage_rc(_t * 16 + _i * 8192, _R, _C); _Pragma("unroll") for (int _h = 0; _h < 2; ++_h) va[_h][_i] = S.arow_off(u, _h * HALF + _R) + (unsigned)_C * 2u; } } while (0)
    Unit cur, nxt; int ui = 0;
    if (!S.next(0, cur)) return;
    typedef typename AccT<Epi::I8>::type acc_t;
    acc_t acc[2][2][4][2];
#pragma unroll
    for (int a = 0; a < 2; ++a)
#pragma unroll
        for (int b = 0; b < 2; ++b)
#pragma unroll
            for (int m = 0; m < 4; ++m)
#pragma unroll
                for (int n = 0; n < 2; ++n) acc[a][b][m][n] = (acc_t){0, 0, 0, 0};
    bf16x8 At[4][2], B0[2][2], B1[2][2]; i32x8 At8[4], B08[2], B18[2];
    unsigned vaC[2][2], vaN[2][2];
    PG8_SETVA(vaC, cur);
    const char* cA = S.a_tile(cur); const char* cB = S.b_tile(cur);
    PG8_STAGE(PG8_SB(0, 0), cB, voffB); PG8_STAGE(PG8_SB(0, 1), cB + hstep, voffB); PG8_STAGE(PG8_SA(0, 0), cA, vaC[0]); PG8_STAGE_A1(PG8_SA(0, 1), cA, vaC);
    if (wr == 1) PG8_BAR;
    PG8_WAIT_V(2); PG8_BAR;
    PG8_STAGE(PG8_SB(1, 0), cB + kstep, voffB); PG8_STAGE(PG8_SA(1, 0), cA + kstep, vaC[0]); PG8_STAGE(PG8_SB(1, 1), cB + hstep + kstep, voffB);
    PG8_WAIT_V(6); PG8_BAR;
    for (;;) {
        const bool has_next = S.next(ui + 1, nxt);
        const char* nA = has_next ? S.a_tile(nxt) : cA; const char* nB = has_next ? S.b_tile(nxt) : cB;
        if (has_next && !Epi::F8) { PG8_SETVA(vaN, nxt); } else {
#pragma unroll
            for (int h = 0; h < 2; ++h)
#pragma unroll
                for (int i = 0; i < 2; ++i) vaN[h][i] = vaC[h][i]; }
        for (int t = 0; t < nt; t += 2) {
            const bool last = (t == nt - 2);
            const char* a1 = cA + (size_t)(t + 1) * kstep;
            const char* a2 = last ? nA : cA + (size_t)(t + 2) * kstep; const char* b2 = last ? nB : cB + (size_t)(t + 2) * kstep;
            if constexpr (Epi::F8) asm volatile("" : "+s"(a1), "+s"(a2), "+s"(b2));
            const char* a3 = a2 + kstep; const char* b3 = b2 + kstep;
            unsigned v2[2][2];
#pragma unroll
            for (int h = 0; h < 2; ++h)
#pragma unroll
                for (int i = 0; i < 2; ++i) v2[h][i] = last ? vaN[h][i] : vaC[h][i];
            PG8_LDB(B0, 0, 0); PG8_LDB(B1, 0, 1); PG8_SCHED; PG8_LDA(At, 0, 0); PG8_STAGE_A1(PG8_SA(1, 1), a1, vaC);
            PG8_WAIT_V(8); PG8_WAIT_L(0); PG8_BAR; PG8_MMA(0, 0, At, B0); PG8_MMA(0, 1, At, B1); PG8_BAR; PG8_SCHED;
            PG8_LDA(At, 0, 1); PG8_STAGE(PG8_SB(0, 0), b2, voffB); PG8_STAGE(PG8_SB(0, 1), b2 + hstep, voffB); PG8_STAGE(PG8_SA(0, 0), a2, v2[0]);
            PG8_WAIT_V(8); PG8_WAIT_L(0); PG8_BAR; PG8_MMA(1, 0, At, B0); PG8_MMA(1, 1, At, B1); PG8_BAR; PG8_SCHED;
            PG8_LDB(B0, 1, 0); PG8_LDB(B1, 1, 1); PG8_SCHED; PG8_LDA(At, 1, 0); PG8_STAGE_A1(PG8_SA(0, 1), a2, v2);
            PG8_WAIT_V(8); PG8_WAIT_L(0); PG8_BAR; PG8_MMA(0, 0, At, B0); PG8_MMA(0, 1, At, B1); PG8_BAR; PG8_SCHED;
            PG8_LDA(At, 1, 1); PG8_STAGE(PG8_SB(1, 0), b3, voffB); PG8_STAGE(PG8_SB(1, 1), b3 + hstep, voffB); PG8_STAGE(PG8_SA(1, 0), a3, v2[0]);
            PG8_WAIT_V(8); PG8_WAIT_L(0); PG8_BAR; PG8_MMA(1, 0, At, B0); PG8_MMA(1, 1, At, B1); PG8_BAR; PG8_SCHED;
        }
        if constexpr (Epi::F8) { asm volatile("s_nop 15\n\ts_nop 15" ::: "memory");
#pragma unroll
            for (int a = 0; a < 2; ++a)
#pragma unroll
                for (int b = 0; b < 2; ++b)
#pragma unroll
                    for (int m = 0; m < 4; ++m) asm volatile("" : "+v"(acc[a][b][m][0]), "+v"(acc[a][b][m][1])); }
        if constexpr (ALIGN_EPI) { if (wr == 0) PG8_BAR; }
        E(acc, cur, wr, wc, fr, fq);
        if (!has_next) break;
#pragma unroll
        for (int a = 0; a < 2; ++a)
#pragma unroll
            for (int b = 0; b < 2; ++b)
#pragma unroll
                for (int m = 0; m < 4; ++m)
#pragma unroll
                    for (int n = 0; n < 2; ++n) acc[a][b][m][n] = (acc_t){0, 0, 0, 0};
        cur = nxt; cA = nA; cB = nB; ++ui;
#pragma unroll
        for (int h = 0; h < 2; ++h)
#pragma unroll
            for (int i = 0; i < 2; ++i) vaC[h][i] = vaN[h][i];
        if constexpr (ALIGN_EPI) { if (wr == 1) PG8_BAR; }
    }
    PG8_WAIT_V(0);
    if constexpr (!ALIGN_EPI) { if (wr == 0) PG8_BAR; }
    PG8_BAR;
#undef PG8_SA
#undef PG8_SB
#undef PG8_STAGE
#undef PG8_STAGE_A1
#undef PG8_LDA
#undef PG8_LDB
#undef PG8_MMA
#undef PG8_WAIT_V
#undef PG8_CAT8
#undef PG8_WAIT_L
#undef PG8_BAR
#undef PG8_SCHED
#undef PG8_SETVA
}
}

#define XB_TMO      128
#define XB_XCNT(j)  (256  + 64 * (j))
#define XB_XSUB(j)  (1280 + 64 * (j))
#define XB_XGEN(j)  (2304 + 64 * (j))
#define XB_TOP      3328
#define XB_TOPGEN   3392
#define XCD_BAR_WORDS 3456
#define XB_SPIN_CAP (1u << 22)
__device__ __forceinline__ unsigned xb_ld(unsigned* p)              { return __hip_atomic_load(p, __ATOMIC_RELAXED, __HIP_MEMORY_SCOPE_AGENT); }
__device__ __forceinline__ unsigned xb_add(unsigned* p, unsigned v) { return __hip_atomic_fetch_add(p, v, __ATOMIC_RELAXED, __HIP_MEMORY_SCOPE_AGENT); }
__device__ __forceinline__ unsigned xb_xcc_id() { return (unsigned)__builtin_amdgcn_s_getreg((3 << 11) | 20) & 0xFu; }
#define XB_SPIN(cond, bar) do { unsigned _sp = 0; while (cond) { __builtin_amdgcn_s_sleep(1); \
    if ((++_sp & 255u) == 0u) { if (xb_ld(&(bar)[XB_TMO])) break; if (_sp > XB_SPIN_CAP) { atomicAdd(&(bar)[XB_TMO], 1u); break; } } } } while (0)
struct XcdBarrier { unsigned* bar; unsigned x; volatile LAS unsigned* st; int wv; };
__device__ __forceinline__ XcdBarrier xcd_barrier_post(unsigned* bar, volatile LAS unsigned* st) {
    XcdBarrier b; b.bar = bar; b.x = xb_xcc_id(); b.st = st;
    if (threadIdx.x == 0) (void)xb_add(&bar[XB_XCNT(b.x)], 1u);
    return b;
}
__device__ __forceinline__ void xcd_barrier_complete(unsigned* bar, unsigned x, unsigned& nloc, unsigned& nx) {
    const unsigned G = gridDim.x * gridDim.y * gridDim.z;
    unsigned sum, cnt, mine, sp = 0u;
    for (;;) {
        sum = 0u; cnt = 0u; mine = 0u;
#pragma nounroll
        for (unsigned j = 0; j < 16; ++j) { const unsigned c = xb_ld(&bar[XB_XCNT(j)]); sum += c; cnt += (c > 0u) ? 1u : 0u; mine = (j == x) ? c : mine; }
        if (sum == G) break;
        __builtin_amdgcn_s_sleep(1);
        if ((++sp & 255u) == 0u) { if (xb_ld(&bar[XB_TMO])) break; if (sp > XB_SPIN_CAP) { atomicAdd(&bar[XB_TMO], 1u); break; } }
    }
    nloc = mine > 0u ? mine : 1u; nx = cnt > 0u ? cnt : 1u;
}
__device__ __forceinline__ void xcd_barrier(const XcdBarrier& b) {
    asm volatile("s_waitcnt vmcnt(0)" ::: "memory");
    __syncthreads();
    if (b.wv == 0 && lane_now() == 0) {
        unsigned* bar = b.bar;
        __builtin_amdgcn_s_waitcnt(0);
        unsigned nloc = b.st[0], nx = b.st[1];
        if (nloc == 0u) { xcd_barrier_complete(bar, b.x, nloc, nx); b.st[0] = nloc; b.st[1] = nx; }
        const unsigned old = xb_add(&bar[XB_XSUB(b.x)], 1u);
        const unsigned gen = old / nloc;
        if (old + 1u == (gen + 1u) * nloc) {
            __builtin_amdgcn_fence(__ATOMIC_RELEASE, "agent");
            asm volatile("s_waitcnt vmcnt(0)" ::: "memory");
            const unsigned og = xb_add(&bar[XB_TOP], 1u);
            const unsigned tg = og / nx;
            if (og + 1u == (tg + 1u) * nx) xb_add(&bar[XB_TOPGEN], 1u);
            else XB_SPIN(xb_ld(&bar[XB_TOPGEN]) == tg, bar);
            __builtin_amdgcn_fence(__ATOMIC_ACQUIRE, "agent");
            xb_add(&bar[XB_XGEN(b.x)], 1u);
            asm volatile("s_waitcnt vmcnt(0)" ::: "memory");
        } else {
            XB_SPIN(xb_ld(&bar[XB_XGEN(b.x)]) == gen, bar);
            __builtin_amdgcn_fence(__ATOMIC_ACQUIRE, "agent");
            asm volatile("s_waitcnt vmcnt(0)" ::: "memory");
        }
    }
    __syncthreads();
}

namespace attn_body {
typedef unsigned short bf16;
using bf16x8=__attribute__((ext_vector_type(8)))short;
using s16x4=__attribute__((ext_vector_type(4)))short;
using f32x16=__attribute__((ext_vector_type(16)))float;
using u32x4=__attribute__((ext_vector_type(4)))unsigned;
constexpr int D=64,DM=NIN,OPITCH=1024;
constexpr int NW=8,QBLK=32,QB=QBLK*NW,KVBLK=64;
__device__ __forceinline__ int crow(int r,int hi){return (r&3)+8*(r>>2)+4*hi;}
#define SBAR() __builtin_amdgcn_sched_barrier(0)
constexpr int NSLOT=3, SLOTB=8192;
constexpr int LDS_K=0, LDS_V=NSLOT*SLOTB, LDS_WS=2*NSLOT*SLOTB, LDS_OST=LDS_WS+NW*64*4, LDS_BYTES=LDS_OST+NW*8192;
__device__ __forceinline__ void glds16(const void*gsrc,unsigned lds_dst){unsigned keep;
  asm volatile("s_mov_b32 %0, m0\n\ts_mov_b32 m0, %2\n\ts_nop 0\n\tglobal_load_lds_dwordx4 %1, off\n\ts_mov_b32 m0, %0":"=&s"(keep):"v"(gsrc),"s"(lds_dst):"memory");}
__device__ __forceinline__ float max3f(float a,float b,float c){float r;asm("v_max3_f32 %0, %1, %2, %3":"=v"(r):"v"(a),"v"(b),"v"(c));return r;}
__device__ __forceinline__ float max2f(float a,float b){float r;asm("v_max_f32_e32 %0, %1, %2":"=v"(r):"v"(a),"v"(b));return r;}
__device__ __forceinline__ float fadd_s(float a,float b){float r;asm("v_add_f32_e32 %0, %1, %2":"=v"(r):"v"(a),"v"(b));return r;}
__device__ __forceinline__ float fsub_s(float a,float b){float r;asm("v_sub_f32_e32 %0, %1, %2":"=v"(r):"v"(a),"v"(b));return r;}
typedef float f32x2_t __attribute__((ext_vector_type(2))); typedef __bf16 bf16x2_t __attribute__((ext_vector_type(2)));
__device__ __forceinline__ unsigned cvtpk_s(float lo,float hi){f32x2_t v={lo,hi};bf16x2_t b=__builtin_convertvector(v,bf16x2_t);return __builtin_bit_cast(unsigned,b);}
#define WAIT_BAR(N) asm volatile("s_waitcnt vmcnt(" #N ") lgkmcnt(0)\n\ts_barrier":::"memory")

__device__ __forceinline__ void qkt(f32x16&p0,f32x16&p1,const char*Kslot,const bf16x8*qr,const f32x16&negm,int r32,int hi){
  const char*kb=Kslot+hi*1024+r32*16;
  #pragma unroll
  for(int d0=0;d0<4;++d0){
    const bf16x8 b0=*reinterpret_cast<const bf16x8*>(kb+d0*2048);
    const bf16x8 b1=*reinterpret_cast<const bf16x8*>(kb+d0*2048+512);
    if(d0==0){p0=__builtin_amdgcn_mfma_f32_32x32x16_bf16(b0,qr[0],negm,0,0,0);p1=__builtin_amdgcn_mfma_f32_32x32x16_bf16(b1,qr[0],negm,0,0,0);}
    else{p0=__builtin_amdgcn_mfma_f32_32x32x16_bf16(b0,qr[d0],p0,0,0,0);p1=__builtin_amdgcn_mfma_f32_32x32x16_bf16(b1,qr[d0],p1,0,0,0);}}
}
typedef __attribute__((address_space(3))) const char* lds_cptr;
typedef short v4i16_t __attribute__((ext_vector_type(4)));
__device__ __forceinline__ void kload8(bf16x8*kf,lds_cptr kp){
  kf[0]=*(const __attribute__((address_space(3))) bf16x8*)(kp);      kf[1]=*(const __attribute__((address_space(3))) bf16x8*)(kp+512);
  kf[2]=*(const __attribute__((address_space(3))) bf16x8*)(kp+2048); kf[3]=*(const __attribute__((address_space(3))) bf16x8*)(kp+2560);
  kf[4]=*(const __attribute__((address_space(3))) bf16x8*)(kp+4096); kf[5]=*(const __attribute__((address_space(3))) bf16x8*)(kp+4608);
  kf[6]=*(const __attribute__((address_space(3))) bf16x8*)(kp+6144); kf[7]=*(const __attribute__((address_space(3))) bf16x8*)(kp+6656);
}
__device__ __forceinline__ void kload2(bf16x8*kf,lds_cptr kp,int j){ kf[2*j]=*(const __attribute__((address_space(3))) bf16x8*)(kp+j*2048); kf[2*j+1]=*(const __attribute__((address_space(3))) bf16x8*)(kp+j*2048+512); }
__device__ __forceinline__ s16x4 vtr(lds_cptr p){ return __builtin_bit_cast(s16x4,__builtin_amdgcn_ds_read_tr16_b64_v4i16((__attribute__((address_space(3))) v4i16_t*)p)); }
__device__ __forceinline__ float rowmax(const f32x16&p0,const f32x16&p1){
  float a=max3f(p0[0],p0[1],p1[0]),b=max3f(p0[2],p0[3],p1[1]);a=max3f(a,p1[2],p1[3]);
  #pragma unroll
  for(int r=4;r<16;r+=4){a=max3f(a,p0[r],p0[r+1]);b=max3f(b,p0[r+2],p0[r+3]);a=max3f(a,p1[r],p1[r+1]);b=max3f(b,p1[r+2],p1[r+3]);}
  const float m=max2f(a,b);
  auto rr=__builtin_amdgcn_permlane32_swap(__float_as_uint(m),__float_as_uint(m),false,false);
  return max2f(__uint_as_float(rr[0]),__uint_as_float(rr[1]));
}
__device__ __forceinline__ void pv(f32x16*o,int vb,bf16x8 pa0,bf16x8 pa1,bf16x8 pa2,bf16x8 pa3){
  #pragma unroll
  for(int d0=0;d0<2;++d0){s16x4 lo[4],hi[4];
    #pragma unroll
    for(int ks=0;ks<4;++ks){
      asm volatile("ds_read_b64_tr_b16 %0,%1 offset:%c2":"=&v"(lo[ks]):"v"(vb),"i"(d0*4096+ks*1024):"memory");
      asm volatile("ds_read_b64_tr_b16 %0,%1 offset:%c2":"=&v"(hi[ks]):"v"(vb),"i"(d0*4096+ks*1024+512):"memory");}
    asm volatile("s_waitcnt lgkmcnt(0)":::"memory");SBAR();
    #define PK(k) (bf16x8){lo[k][0],lo[k][1],lo[k][2],lo[k][3],hi[k][0],hi[k][1],hi[k][2],hi[k][3]}
    o[d0]=__builtin_amdgcn_mfma_f32_32x32x16_bf16(pa0,PK(0),o[d0],0,0,0);
    o[d0]=__builtin_amdgcn_mfma_f32_32x32x16_bf16(pa1,PK(1),o[d0],0,0,0);
    o[d0]=__builtin_amdgcn_mfma_f32_32x32x16_bf16(pa2,PK(2),o[d0],0,0,0);
    o[d0]=__builtin_amdgcn_mfma_f32_32x32x16_bf16(pa3,PK(3),o[d0],0,0,0);
    #undef PK
  }
}

template<int THRL,int EPI> __device__ __forceinline__ void attn_unit(const bf16*Q0,const bf16*__restrict__ Kb,const bf16*__restrict__ Vb,long dC,int ntL,int NT,unsigned char*Y0,float lam,float oml,const float*subln,char*shm,int wv){
  const int tid_=wv*64+lane_now();
  const int tid=tid_,lane=tid&63,r32=lane&31,hi=lane>>5; const int wid=__builtin_amdgcn_readfirstlane(tid>>6);
  const bf16*Qw=Q0+(long)(wid*QBLK)*DM;
  const bf16*Kh=Kb,*Vh=Vb;
  const unsigned lds0=(unsigned)(uintptr_t)shm;
  float*wsf=(float*)(shm+LDS_WS)+wid*64;
  const bf16*ksrc=Kh+(long)lane*DM+wid*8;
  const bf16*vsrc=Vh+(long)(16*(wid&3)+(lane>>2))*DM+(wid>>2)*32+(lane&3)*8;
  const unsigned kdst=lds0+LDS_K+wid*1024, vdst=lds0+LDS_V+wid*1024;
  #define TOFF(t) ((long)(t)*KVBLK*DM+(((t)<ntL)?0l:dC))
  #define DMA_K(t,slot) glds16(ksrc+TOFF(t),(unsigned)__builtin_amdgcn_readfirstlane(kdst+(slot)))
  #define DMA_V(t,slot) glds16(vsrc+TOFF(t),(unsigned)__builtin_amdgcn_readfirstlane(vdst+(slot)))
  const int vb0=(int)(lds0+LDS_V)+((lane>>4)&1)*32+(lane&3)*8+(4*hi+((lane&15)>>2))*64;
  const char*Kbase=shm+LDS_K; bf16x8 kf[8];
  const lds_cptr shm3=(lds_cptr)shm; const lds_cptr kp0=shm3+LDS_K+hi*1024+r32*16; const lds_cptr vp0=shm3+LDS_V+((lane>>4)&1)*32+(lane&3)*8+(4*hi+((lane&15)>>2))*64;
  DMA_K(0,0);DMA_V(0,0);DMA_K(1,SLOTB);
  bf16x8 qr[4];
  if(EPI==0){
    #pragma unroll
    for(int d0=0;d0<4;++d0)qr[d0]=*reinterpret_cast<const bf16x8*>(&Qw[(long)r32*DM+d0*16+hi*8]);
  }else{ const bf16x8 z={0,0,0,0,0,0,0,0}; const bf16x8 f0=*reinterpret_cast<const bf16x8*>(&Qw[(long)r32*DM+hi*8]),f1=*reinterpret_cast<const bf16x8*>(&Qw[(long)r32*DM+16+hi*8]);
    qr[0]=EPI==1?f0:z; qr[1]=EPI==1?f1:z; qr[2]=EPI==2?f0:z; qr[3]=EPI==2?f1:z; }
  float mhat=0.f,l_reg=0.f;f32x16 o[2];o[0]=f32x16{};o[1]=f32x16{};f32x16 negm=f32x16{};asm volatile("":"+v"(negm));
  #define CMASK(P0,P1,t) do{}while(0)
  bool resc=false;
  #define START(P0,P1) do{ const float rm=rowmax(P0,P1); resc=false; \
    { const float dl=rm; mhat=fadd_s(mhat,dl); \
      _Pragma("unroll") for(int r=0;r<16;++r){P0[r]=fsub_s(P0[r],dl);P1[r]=fsub_s(P1[r],dl);} \
      _Pragma("unroll") for(int r=0;r<16;++r)negm[r]=-mhat; asm volatile("":"+v"(negm)); } \
    _Pragma("unroll") for(int r=0;r<16;++r)P0[r]=__builtin_amdgcn_exp2f(P0[r]); }while(0)
  #define RESC() do{ if(resc){ asm volatile("s_waitcnt lgkmcnt(0)":::"memory"); \
      _Pragma("unroll") for(int d_=0;d_<2;++d_) _Pragma("unroll") for(int r=0;r<16;++r)o[d_][r]*=wsf[crow(r,hi)]; } }while(0)
  f32x16 pA0,pA1,pB0,pB1;
  int sl_prev=0,sl_cur=0,sl_next=SLOTB;
  #define ROT() do{sl_prev=sl_cur;sl_cur=sl_next;sl_next=(sl_next==(NSLOT-1)*SLOTB)?0:sl_next+SLOTB;}while(0)
  DMA_K(2,2*SLOTB);
  WAIT_BAR(3);
  qkt(pA0,pA1,Kbase,qr,negm,r32,hi);asm volatile("s_nop 15\n\ts_nop 7":"+v"(pA0),"+v"(pA1));CMASK(pA0,pA1,0);
  START(pA0,pA1);
  _Pragma("unroll") for(int r=0;r<16;++r)pA1[r]=__builtin_amdgcn_exp2f(pA1[r]);
  WAIT_BAR(0);
  DMA_K(3,0);DMA_V(1,SLOTB);
  ROT();
  kload8(kf,kp0+sl_cur);
  WAIT_BAR(2);
  s16x4 vlo[8],vhi[8]; u32x4 pw0,pw1,pw2,pw3;
  #define PKW(P,B) cvtpk_s(P[B],P[B+1])
  #define PAF(k) __builtin_bit_cast(bf16x8,pw##k)
  #define VFR(i) (bf16x8){vlo[i][0],vlo[i][1],vlo[i][2],vlo[i][3],vhi[i][0],vhi[i][1],vhi[i][2],vhi[i][3]}
  #define PIN(x) asm volatile("":"+v"(x))
  #define MX3(a,b,c) __builtin_fmaxf(__builtin_fmaxf((a),(b)),(c))
  #define GAPA(MF,A0,A1,A2,A3,W0,W1,PW) do{ MF; sacc+=A0; sacc+=A1; sacc+=A2; sacc+=A3; PIN(sacc); W0; W1; PIN(PW); SBAR(); }while(0)
  #define EX(v) __builtin_amdgcn_exp2f(v)
  #define GAPB(MF,X,B) do{ MF; X[B]=EX(X[B]); X[B+1]=EX(X[B+1]); X[B+2]=EX(X[B+2]); X[B+3]=EX(X[B+3]); PIN(X); SBAR(); }while(0)
  #define VRD(i) do{ vlo[i]=vtr(vp_+(((i)>>2)*4096+((i)&3)*1024)); vhi[i]=vtr(vp_+(((i)>>2)*4096+((i)&3)*1024+512)); }while(0)
  #define KRD(G,j) do{ if((G)&&(EPI==0||(EPI==1&&(j)<2)||(EPI==2&&(j)>=2))){ kload2(kf,kp0+sl_next,j); SBAR(); } }while(0)
  #define STEP(C0,C1,P0,P1,t,GK,GV,GL) do{ SBAR(); \
    const lds_cptr vp_=vp0+sl_prev; \
    VRD(0); SBAR(); float sacc=(P0[0]+P0[1]); \
    GAPA(if(EPI!=2)C0=__builtin_amdgcn_mfma_f32_32x32x16_bf16(kf[0],qr[0],negm,0,0,0), P0[2],P0[3],P0[4],P0[5],     pw0[0]=PKW(P0,0), pw0[1]=PKW(P0,2), pw0); \
    VRD(4); SBAR(); GAPA(if(EPI!=2)C1=__builtin_amdgcn_mfma_f32_32x32x16_bf16(kf[1],qr[0],negm,0,0,0), P0[6],P0[7],P0[8],P0[9],     pw0[2]=PKW(P0,4), pw0[3]=PKW(P0,6), pw0); \
    VRD(1); SBAR(); GAPA(if(EPI!=2)C0=__builtin_amdgcn_mfma_f32_32x32x16_bf16(kf[2],qr[1],C0,0,0,0),   P0[10],P0[11],P0[12],P0[13], pw1[0]=PKW(P0,8), pw1[1]=PKW(P0,10), pw1); \
    VRD(5); SBAR(); GAPA(if(EPI!=2)C1=__builtin_amdgcn_mfma_f32_32x32x16_bf16(kf[3],qr[1],C1,0,0,0),   P0[14],P0[15],P1[0],P1[1],   pw1[2]=PKW(P0,12),pw1[3]=PKW(P0,14), pw1); \
    VRD(2); SBAR(); GAPA(if(EPI!=1)C0=__builtin_amdgcn_mfma_f32_32x32x16_bf16(kf[4],qr[2],EPI==2?negm:C0,0,0,0),   P1[2],P1[3],P1[4],P1[5],     pw2[0]=PKW(P1,0), pw2[1]=PKW(P1,2), pw2); \
    VRD(6); SBAR(); GAPA(if(EPI!=1)C1=__builtin_amdgcn_mfma_f32_32x32x16_bf16(kf[5],qr[2],EPI==2?negm:C1,0,0,0),   P1[6],P1[7],P1[8],P1[9],     pw2[2]=PKW(P1,4), pw2[3]=PKW(P1,6), pw2); \
    VRD(3); SBAR(); GAPA(if(EPI!=1)C0=__builtin_amdgcn_mfma_f32_32x32x16_bf16(kf[6],qr[3],C0,0,0,0),   P1[10],P1[11],P1[12],P1[13], pw3[0]=PKW(P1,8), pw3[1]=PKW(P1,10), pw3); \
    VRD(7); SBAR(); GAPA(if(EPI!=1)C1=__builtin_amdgcn_mfma_f32_32x32x16_bf16(kf[7],qr[3],C1,0,0,0),   P1[14],P1[15],0.f,0.f,       pw3[2]=PKW(P1,12),pw3[3]=PKW(P1,14), pw3); \
    l_reg+=sacc; \
    if(GK){DMA_K((t)+3,sl_cur);} if(GV){DMA_V((t)+1,sl_next);} \
    CMASK(C0,C1,t); \
    { float a=MX3(C0[0],C0[1],C1[0]),b=MX3(C0[2],C0[3],C1[1]); a=MX3(a,C1[2],C1[3]); \
      _Pragma("unroll") for(int r=4;r<16;r+=4){a=MX3(a,C0[r],C0[r+1]);b=MX3(b,C0[r+2],C0[r+3]);a=MX3(a,C1[r],C1[r+1]);b=MX3(b,C1[r+2],C1[r+3]);} \
      float rm=__builtin_fmaxf(a,b); { auto rr=__builtin_amdgcn_permlane32_swap(__float_as_uint(rm),__float_as_uint(rm),false,false); rm=__builtin_fmaxf(__uint_as_float(rr[0]),__uint_as_float(rr[1])); } \
      resc=false; \
      if(__builtin_expect(__any(rm>(float)THRL),0)){ const float dl=__builtin_fmaxf(rm,0.f); mhat+=dl; \
        _Pragma("unroll") for(int r=0;r<16;++r){C0[r]-=dl;C1[r]-=dl;} \
        _Pragma("unroll") for(int r=0;r<16;++r)negm[r]=-mhat; asm volatile("":"+v"(negm)); \
        const float f=__builtin_amdgcn_exp2f(-dl); l_reg*=f; if(hi==0)wsf[r32]=f; resc=true; } } \
    SBAR(); \
    GAPB(o[0]=__builtin_amdgcn_mfma_f32_32x32x16_bf16(PAF(0),VFR(0),o[0],0,0,0), C0,0); \
    GAPB(o[1]=__builtin_amdgcn_mfma_f32_32x32x16_bf16(PAF(0),VFR(4),o[1],0,0,0), C0,4); \
    KRD(GL,0); GAPB(o[0]=__builtin_amdgcn_mfma_f32_32x32x16_bf16(PAF(1),VFR(1),o[0],0,0,0), C0,8); \
    KRD(GL,1); GAPB(o[1]=__builtin_amdgcn_mfma_f32_32x32x16_bf16(PAF(1),VFR(5),o[1],0,0,0), C0,12); \
    KRD(GL,2); GAPB(o[0]=__builtin_amdgcn_mfma_f32_32x32x16_bf16(PAF(2),VFR(2),o[0],0,0,0), C1,0); \
    KRD(GL,3); GAPB(o[1]=__builtin_amdgcn_mfma_f32_32x32x16_bf16(PAF(2),VFR(6),o[1],0,0,0), C1,4); \
    GAPB(o[0]=__builtin_amdgcn_mfma_f32_32x32x16_bf16(PAF(3),VFR(3),o[0],0,0,0), C1,8); \
    GAPB(o[1]=__builtin_amdgcn_mfma_f32_32x32x16_bf16(PAF(3),VFR(7),o[1],0,0,0), C1,12); \
    }while(0)
  int t=1;
  for(;t+5<NT;t+=2){
    STEP(pB0,pB1,pA0,pA1,t,true,true,true);     WAIT_BAR(2); RESC(); ROT();
    STEP(pA0,pA1,pB0,pB1,t+1,true,true,true);   WAIT_BAR(2); RESC(); ROT();
  }
  #define ENDW(tt) do{ if((tt)+3<NT){WAIT_BAR(2);} else if((tt)+2<NT){WAIT_BAR(1);} else {WAIT_BAR(0);} }while(0)
  for(;t+1<NT;t+=2){
    STEP(pB0,pB1,pA0,pA1,t,(t+3<NT),(t+1<NT),(t+1<NT));       ENDW(t);   RESC(); ROT();
    STEP(pA0,pA1,pB0,pB1,t+1,(t+4<NT),(t+2<NT),(t+2<NT));     ENDW(t+1); RESC(); ROT();
  }
  STEP(pB0,pB1,pA0,pA1,NT-1,false,false,false); RESC();
  { float sacc=pB0[0]+pB0[1]; _Pragma("unroll") for(int r=2;r<16;++r)sacc+=pB0[r]; _Pragma("unroll") for(int r=0;r<16;++r)sacc+=pB1[r]; l_reg+=sacc;
    pw0=(u32x4){PKW(pB0,0),PKW(pB0,2),PKW(pB0,4),PKW(pB0,6)};pw1=(u32x4){PKW(pB0,8),PKW(pB0,10),PKW(pB0,12),PKW(pB0,14)};pw2=(u32x4){PKW(pB1,0),PKW(pB1,2),PKW(pB1,4),PKW(pB1,6)};pw3=(u32x4){PKW(pB1,8),PKW(pB1,10),PKW(pB1,12),PKW(pB1,14)};
    SBAR(); pv(o,vb0+sl_cur,PAF(0),PAF(1),PAF(2),PAF(3)); }
  #undef PKW
  #undef PAF
  #undef VFR
  #undef PIN
  #undef MX3
  #undef GAPA
  #undef GAPB
  #undef EX
  #undef VRD
  #undef KRD
  #undef STEP
  #undef ENDW
  l_reg=sum32(l_reg);
  if(hi==0)wsf[32+r32]=l_reg;asm volatile("s_waitcnt lgkmcnt(0)":::"memory");
  float rli[16];
  #pragma unroll
  for(int r=0;r<16;++r)rli[r]=__builtin_amdgcn_rcpf(wsf[32+crow(r,hi)]);
  { float*stg=(float*)(shm+LDS_OST)+wid*2048;
    #pragma unroll
    for(int r=0;r<16;++r){const int orow=crow(r,hi);
      #pragma unroll
      for(int d0=0;d0<2;++d0){ const int ix=orow*64+d0*32+r32; const float v=o[d0][r]*rli[r]; if(EPI==2)stg[ix]=stg[ix]-lam*v; else stg[ix]=v; } }
    asm volatile("s_waitcnt lgkmcnt(0)":::"memory");
    if(EPI!=1){ unsigned char*Yw=Y0+(long)(wid*QBLK)*OPITCH;
      #pragma unroll
      for(int i=0;i<4;++i){const int row=i*8+(lane>>3),ch=lane&7; const f32x4 a=*(const f32x4*)(stg+row*64+ch*8),b=*(const f32x4*)(stg+row*64+ch*8+4);
        float v[8]={a[0],a[1],a[2],a[3],b[0],b[1],b[2],b[3]};
        if(EPI==2){ float ss=0.f;
          #pragma unroll
          for(int j=0;j<8;++j)ss+=v[j]*v[j];
          ss+=shx<1>(ss);ss+=shx<2>(ss);ss+=shx<4>(ss);
          const float rs=rsqrtf(ss*(1.0f/64.0f)+EPS)*oml;
          #pragma unroll
          for(int j=0;j<8;++j)v[j]=v[j]*rs*subln[ch*8+j]; }
        *(u32x2*)(Yw+(long)row*OPITCH+ch*8)=pack8_fp8(v,SY8);} } }
  asm volatile("s_waitcnt lgkmcnt(0)\n\ts_barrier":::"memory");
  #undef DMA_K
  #undef DMA_V
  #undef TOFF
  #undef CMASK
  #undef START
  #undef RESC
  #undef ROT
}
constexpr int ATTN_LDS_BYTES=LDS_BYTES;
#undef SBAR
#undef WAIT_BAR
}

constexpr int RING_BYTES = 131072, LDSCTL_OFF = RING_BYTES, MISC_OFF = LDSCTL_OFF + 320, LDS_BYTES = 147456;

__device__ __forceinline__ void conv_load_z(const bf16* pr, int ch, bool ok, float (&z)[8]) {
    const u32x4 zz = {0, 0, 0, 0}; const u32x4 u = ok ? *(const u32x4*)(pr + 768 + ch) : zz, c = ok ? *(const u32x4*)(pr + 1280 + ch) : zz; float a[8], b[8]; unpack8(u, a); unpack8(c, b);
#pragma unroll
    for (int k = 0; k < 8; ++k) z[k] = a[k] * b[k];
}
template <int HN> __device__ __forceinline__ void conv_rows_t(const bf16* P, unsigned char* Y, const float* convw, int r0, int lane) {
    const int ch = (lane & 31) * 8, rb = r0 + (lane >> 5) * HN;
    float w[3][8];
#pragma unroll
    for (int j = 0; j < 3; ++j) { const f32x4 a = *(const f32x4*)(convw + j * 256 + ch), b = *(const f32x4*)(convw + j * 256 + ch + 4); w[j][0] = a[0]; w[j][1] = a[1]; w[j][2] = a[2]; w[j][3] = a[3]; w[j][4] = b[0]; w[j][5] = b[1]; w[j][6] = b[2]; w[j][7] = b[3]; }
    u32x4 zu[HN + 2], zc[HN + 2], bbw[HN]; const u32x4 zz = {0, 0, 0, 0};
#pragma unroll
    for (int i = 0; i < HN + 2; ++i) { const int row = rb + i - 1; const bool ok = row >= 0 && row < MT; const bf16* pr = P + (size_t)(ok ? row : 0) * NIN;
        zu[i] = ok ? *(const u32x4*)(pr + 768 + ch) : zz; zc[i] = ok ? *(const u32x4*)(pr + 1280 + ch) : zz; }
#pragma unroll
    for (int i = 0; i < HN; ++i) bbw[i] = *(const u32x4*)(P + (size_t)(rb + i) * NIN + 1024 + ch);
    float zm[8], z0[8], zp[8];
    { float a[8], b[8]; unpack8(zu[0], a); unpack8(zc[0], b);
#pragma unroll
      for (int k = 0; k < 8; ++k) zm[k] = a[k] * b[k];
      unpack8(zu[1], a); unpack8(zc[1], b);
#pragma unroll
      for (int k = 0; k < 8; ++k) z0[k] = a[k] * b[k]; }
#pragma unroll
    for (int i = 0; i < HN; ++i) { const int row = rb + i; const bool lat = row < ML; const int t = lat ? (row & 2047) : ((row - ML) & 255); const int slen = lat ? SEQ : CTX;
        float a[8], b[8], bb[8], o[8]; unpack8(zu[i + 2], a); unpack8(zc[i + 2], b); unpack8(bbw[i], bb); const bool hm = t > 0, hp = t + 1 < slen;
#pragma unroll
        for (int k = 0; k < 8; ++k) { zp[k] = a[k] * b[k]; o[k] = bb[k] * ((hm ? w[0][k] * zm[k] : 0.0f) + w[1][k] * z0[k] + (hp ? w[2][k] * zp[k] : 0.0f)); zm[k] = z0[k]; z0[k] = zp[k]; }
        *(u32x2*)(Y + (size_t)row * D + 512 + ch) = pack8_fp8(o, SY8); }
}
__device__ __forceinline__ void conv_rows(const bf16* P, unsigned char* Y, const float* convw, int r0, int nr, int lane) { if (nr == 18) conv_rows_t<9>(P, Y, convw, r0, lane); else conv_rows_t<8>(P, Y, convw, r0, lane); }
__device__ __forceinline__ void norm2_router_phase(const NormArgs& a, LAS unsigned char* lds, int vcu, int NGW, int tid, int lane, int wave) {
    LAS float* rwT = (LAS float*)lds;
    LAS unsigned* sel = (LAS unsigned*)(lds + 32768);
    LAS float* gat = (LAS float*)(lds + 32768 + 1024);
    LAS unsigned* lcnt = (LAS unsigned*)(lds + 32768 + 1024 + 2048);
    LAS unsigned* gbase = lcnt + 16; LAS float* rsw = (LAS float*)(gbase + 16);
    for (int i = tid; i < 8192; i += 512) rwT[(i & 7) * 1024 + (i >> 3)] = a.rw[i];
    if (tid < 16) lcnt[tid] = 0u;
    __syncthreads();
    const int rpw = a.nrows / NGW, wgrow0 = vcu * 8 * rpw;
    u32x2 vn[4]; f32x4 avn[4], svn[4];
    { const int row_ = wgrow0 + wave * rpw, b_ = row_ < ML ? row_ >> 11 : 16; const u32x2* xr = (const u32x2*)(a.XB + (size_t)row_ * D);
      const float* A_ = a.MODl + ((size_t)b_ * 6 + a.jA) * 1024; const float* S_ = a.MODl + ((size_t)b_ * 6 + a.jS) * 1024;
#pragma unroll
      for (int j = 0; j < 4; ++j) { vn[j] = xr[lane + 64 * j]; avn[j] = *(const f32x4*)(A_ + 4 * lane + 256 * j); svn[j] = *(const f32x4*)(S_ + 4 * lane + 256 * j); } }
    for (int i = 0; i < rpw; ++i) { const int rl = wave * rpw + i, row = wgrow0 + rl;
        f32x4 v[4], avc[4], svc[4]; float ss = 0.f;
#pragma unroll
        for (int j = 0; j < 4; ++j) { unpack4(vn[j], v[j]); avc[j] = avn[j]; svc[j] = svn[j]; ss += (v[j].x * v[j].x + v[j].y * v[j].y) + (v[j].z * v[j].z + v[j].w * v[j].w); }
        if (i + 1 < rpw) { const int b_ = row + 1 < ML ? (row + 1) >> 11 : 16; const u32x2* xr = (const u32x2*)(a.XB + (size_t)(row + 1) * D);
            const float* A_ = a.MODl + ((size_t)b_ * 6 + a.jA) * 1024; const float* S_ = a.MODl + ((size_t)b_ * 6 + a.jS) * 1024;
#pragma unroll
            for (int j = 0; j < 4; ++j) { vn[j] = xr[lane + 64 * j]; avn[j] = *(const f32x4*)(A_ + 4 * lane + 256 * j); svn[j] = *(const f32x4*)(S_ + 4 * lane + 256 * j); } }
        const float rstd = rsqrtf(wave_sum(ss) * (1.0f / D) + EPS);
#pragma unroll
        for (int j = 0; j < 4; ++j) v[j] = v[j] * rstd * avc[j] + svc[j];
        const float rsv = write_row_i8(v, (signed char*)a.H + (size_t)row * D, a.rs8 + row, lane);
        float lg[8];
#pragma unroll
        for (int e = 0; e < 8; ++e) { float s = 0.f;
#pragma unroll
            for (int j = 0; j < 4; ++j) { const f32x4 w4 = *(const LAS f32x4*)(rwT + e * 1024 + 4 * lane + 256 * j); s += (v[j].x * w4.x + v[j].y * w4.y) + (v[j].z * w4.z + v[j].w * w4.w); }
            lg[e] = wave_sum(s) + a.rb[e]; }
        int e0 = 0; float v0 = lg[0];
#pragma unroll
        for (int e = 1; e < 8; ++e) if (lg[e] > v0) { v0 = lg[e]; e0 = e; }
        int e1 = -1; float v1 = -3.0e38f;
#pragma unroll
        for (int e = 0; e < 8; ++e) if (e != e0 && lg[e] > v1) { v1 = lg[e]; e1 = e; }
        if (e1 < 0) e1 = (e0 + 1) & 7;
        const float g0 = 1.0f / (1.0f + expf(v1 - v0)), g1 = 1.0f - g0;
        if (lane == 0) { const unsigned s0 = __hip_atomic_fetch_add(lcnt + e0, 1u, __ATOMIC_RELAXED, __HIP_MEMORY_SCOPE_WORKGROUP), s1 = __hip_atomic_fetch_add(lcnt + 8 + e1, 1u, __ATOMIC_RELAXED, __HIP_MEMORY_SCOPE_WORKGROUP);
            sel[rl] = (unsigned)e0 | ((unsigned)e1 << 4) | (s0 << 8) | (s1 << 16); gat[2 * rl] = g0; gat[2 * rl + 1] = g1; rsw[rl] = rsv; }
    }
    __syncthreads();
    if (tid < 16) gbase[tid] = atomicAdd(a.cnt + tid, lcnt[tid]);
    __syncthreads();
    if (tid < 8 * rpw) { const unsigned sv = sel[tid]; const int e0 = sv & 15, e1 = (sv >> 4) & 15, s0 = (sv >> 8) & 255, s1 = (sv >> 16) & 255, row = wgrow0 + tid;
        const size_t i0 = (size_t)e0 * MT + gbase[e0] + s0, i1 = (size_t)(8 + e1) * MT + gbase[8 + e1] + s1;
        a.list[i0] = row; a.glist[i0] = gat[2 * tid]; a.list[i1] = row; a.glist[i1] = gat[2 * tid + 1]; a.rsl[i0] = rsw[tid]; a.rsl[i1] = rsw[tid]; }
    __syncthreads();
}

struct Args { const float* in[25]; float* out; unsigned char* ws; int ph_lo, ph_hi, li, pad; };
constexpr int PH_PER_LAYER = 12, PH_L0 = 2, PH_FINAL = PH_L0 + 4 * PH_PER_LAYER, N_PHASES = PH_FINAL + 1;
constexpr int CW_CMAX = 131072;
constexpr size_t WS_H8A = WS_P + 200 * MiB;
constexpr int CW_CMAX2 = CW_CMAX + 18 * NUP;
constexpr size_t WS_RS = WS_TAB + 256 * 1024;
enum { PH_NORM1 = 0, PH_INPROJ = 1, PH_POST = 2, PH_ATTN = 3, PH_OUTPROJ = 4, PH_NORM2 = 5, PH_UP0 = 6, PH_DN0 = 7, PH_UP1 = 8, PH_DN1 = 9 };

__global__ void __launch_bounds__(512, 2) mk_fwd(Args args) {
    extern __shared__ __attribute__((aligned(16))) unsigned char lds_raw[];
    LAS unsigned char* lds = (LAS unsigned char*)lds_raw;
    volatile LAS unsigned* MISC = (volatile LAS unsigned*)(lds + MISC_OFF);
    const int tid0 = threadIdx.x; const int wave_s = __builtin_amdgcn_readfirstlane(tid0 >> 6);
    const int G = gridDim.x, bx = blockIdx.x; const int vcu = (G % 8 == 0) ? (bx % 8) * (G / 8) + bx / 8 : bx;
    const int NGW = G * 8;
    unsigned char* ws = args.ws; float* out = args.out;
    unsigned* CTL = (unsigned*)(ws + WS_CTL); float* MOD = (float*)(ws + WS_MOD); float* TAB = (float*)(ws + WS_TAB);
    int* LIST = (int*)(ws + WS_MOE + MOE_LIST); float* GL = (float*)(ws + WS_MOE + MOE_GATE);
    bf16* XB = (bf16*)(ws + WS_XB); bf16* H = (bf16*)(ws + WS_H); bf16* P = (bf16*)(ws + WS_P);
    for (int u = tid0; u < (LDS_BYTES - LDSCTL_OFF) / 4; u += 512) ((LAS unsigned*)(lds + LDSCTL_OFF))[u] = 0u;
    __syncthreads();
    const int lo = args.ph_lo, hi = args.ph_hi; const bool multi = (hi - lo) > 1;
    XcdBarrier bar; bar.bar = CTL + CW_BAR + args.li * XCD_BAR_WORDS; bar.x = 0; bar.st = nullptr; bar.wv = wave_s;
    if (multi) { bar = xcd_barrier_post(CTL + CW_BAR + args.li * XCD_BAR_WORDS, MISC + 8); bar.wv = wave_s; }
#define IN(k) (lo <= (k) && (k) < hi)
#define PHASE_LOCALS const int tid_p = wave_s * 64 + lane_now(); const int lane = tid_p & 63, wave = wave_s, gw = vcu * 8 + wave, tid = tid_p; (void)lane; (void)wave; (void)gw; (void)tid; \
    unsigned char* ws_p = args.ws; asm volatile("" : "+s"(ws_p)); unsigned char* const ws = ws_p;     \
    unsigned* const CTL = (unsigned*)(ws + WS_CTL); float* const MOD = (float*)(ws + WS_MOD); float* const TAB = (float*)(ws + WS_TAB); int* const LIST = (int*)(ws + WS_MOE + MOE_LIST); float* const GL = (float*)(ws + WS_MOE + MOE_GATE); \
    bf16* const XB = (bf16*)(ws + WS_XB); bf16* const H = (bf16*)(ws + WS_H); bf16* const P = (bf16*)(ws + WS_P); (void)CTL; (void)MOD; (void)TAB; (void)LIST; (void)GL; (void)XB; (void)H; (void)P;
#define SEAM(k) do { if (multi && (k) + 1 < hi) xcd_barrier(bar); } while (0)
constexpr int QPRO = 450;
#define DEFER_Q(tot_, f0_, f1_) do { if (l < DEPTH - 1) { const int jl_ = l == 0 ? 0 : 1, qn_ = l == 0 ? 1408 - QPRO : 704, qb_ = 640 + jl_ * 1408 + (l == 2 ? 704 : l == 0 ? QPRO : 0), r_ = (tot_) % G; \
        const int a_ = qb_ + (qn_ * (f0_)) / 100, b_ = qb_ + (qn_ * (f1_)) / 100; if (r_ == 0) run_q(a_, b_, bx, G); else if (bx >= r_) run_q(a_, b_, bx - r_, G - r_); } } while (0)
#define DEFER_T(tot_) do { if (l < DEPTH - 1) { const int jl_ = l == 0 ? 0 : 1, tn_ = l == 0 ? 11264 : 5632, tb_ = 4864 + jl_ * 11264 + (l == 2 ? 5632 : 0), r_ = (tot_) % G; \
        if (r_ == 0) run_tr(tb_, tb_ + tn_, bx * 8 + wave_s, G * 8); else if (bx >= r_) run_tr(tb_, tb_ + tn_, (bx - r_) * 8 + wave_s, (G - r_) * 8); } } while (0)

    auto run_tr = [&](int lo_, int hi_, int first_, int step_) __attribute__((always_inline)) {   PHASE_LOCALS
            LAS float* scr = (LAS float*)(lds + wave * 16384);
#define P0_DEC1(it, src, dst, KK, sc8) do { sc8 = 0.f; if ((it) < 2048) { const int l_ = (it) >> 9, r2_ = (it) & 511, kb_ = r2_ >> 5, nb_ = r2_ & 31; src = args.in[9] + (size_t)l_ * D * D + (size_t)(64 * kb_) * D + 32 * nb_; \
                dst = (bf16*)((unsigned char*)(ws + WS_WOUT) + (size_t)l_ * D * D + (size_t)(32 * nb_) * D + 64 * kb_); KK = D; sc8 = f8l[4 * (18 + l_)]; } \
            else { const int it2_ = (it) - 2048, set_ = it2_ / 1408, r2_ = it2_ % 1408, kb_ = r2_ >> 5, nb_ = r2_ & 31; const bool dn_ = set_ < 2; const int si_ = dn_ ? set_ : set_ - 2; \
                src = (dn_ ? args.in[19] : args.in[24]) + (size_t)si_ * DFF * D + (size_t)(64 * kb_) * D + 32 * nb_; dst = (bf16*)((unsigned char*)(ws + (dn_ ? WS_DDN : WS_MDN)) + (size_t)si_ * D * DFF + (size_t)(32 * nb_) * DFF + 64 * kb_); KK = DFF; sc8 = f8l[4 * set_]; } } while (0)
#define P0_LOAD1(src, v) do { _Pragma("unroll") for (int i_ = 0; i_ < 8; ++i_) v[i_] = *(const f32x4*)((src) + (size_t)(8 * i_ + (lane >> 3)) * D + 4 * (lane & 7)); } while (0)
            LAS float* f8l = (LAS float*)(lds + LDSCTL_OFF + 2048);
            const float* srcC; bf16* dstC; int KC; float scC; f32x4 va[8], vb[8];
            int it = lo_ + first_; if (it < hi_) { P0_DEC1(it, srcC, dstC, KC, scC); P0_LOAD1(srcC, va); }
            for (; it < hi_; it += step_) { const float* srcN = srcC; bf16* dstN = dstC; int KN = KC; float scN = scC; const bool hn = it + step_ < hi_;
                if (hn) { P0_DEC1(it + step_, srcN, dstN, KN, scN); P0_LOAD1(srcN, vb); }
#pragma unroll
                for (int i = 0; i < 8; ++i) { const int kk = 8 * i + (lane >> 3), q4 = 4 * (lane & 7); scr[kk * 33 + q4] = va[i][0]; scr[kk * 33 + q4 + 1] = va[i][1]; scr[kk * 33 + q4 + 2] = va[i][2]; scr[kk * 33 + q4 + 3] = va[i][3]; }
                asm volatile("s_waitcnt lgkmcnt(0)" ::: "memory");
                if (scC != 0.f) {
                    const int c4 = lane & 3; unsigned char* d8 = (unsigned char*)dstC;
#pragma unroll
                    for (int j = 0; j < 2; ++j) { const int n = (lane >> 2) + 16 * j; const LAS float* sp = scr + (16 * c4) * 33 + n; int w4[4];
#pragma unroll
                        for (int q = 0; q < 4; ++q) { const float a0 = fminf(fmaxf(sp[(4 * q) * 33] * scC, -448.f), 448.f), a1 = fminf(fmaxf(sp[(4 * q + 1) * 33] * scC, -448.f), 448.f), a2 = fminf(fmaxf(sp[(4 * q + 2) * 33] * scC, -448.f), 448.f), a3 = fminf(fmaxf(sp[(4 * q + 3) * 33] * scC, -448.f), 448.f);
                            int w = 0; w = __builtin_amdgcn_cvt_pk_fp8_f32(a0, a1, w, false); w = __builtin_amdgcn_cvt_pk_fp8_f32(a2, a3, w, true); w4[q] = w; }
                        *(u32x4*)(d8 + (size_t)n * KC + 16 * c4) = (u32x4){(unsigned)w4[0], (unsigned)w4[1], (unsigned)w4[2], (unsigned)w4[3]}; }
                } else {
                const int c = lane & 7;
#pragma unroll
                for (int j = 0; j < 4; ++j) { const int n = (lane >> 3) + 8 * j; const LAS float* sp = scr + (8 * c) * 33 + n;
                    u32x4 o; o.x = pk2(sp[0 * 33], sp[1 * 33]); o.y = pk2(sp[2 * 33], sp[3 * 33]); o.z = pk2(sp[4 * 33], sp[5 * 33]); o.w = pk2(sp[6 * 33], sp[7 * 33]);
                    *(u32x4*)(dstC + (size_t)n * KC + 8 * c) = o; }
                }
                asm volatile("s_waitcnt lgkmcnt(0)" ::: "memory");
                srcC = srcN; dstC = dstN; KC = KN; scC = scN;
#pragma unroll
                for (int i = 0; i < 8; ++i) va[i] = vb[i]; }
#undef P0_DEC1
#undef P0_LOAD1
    };
    auto run_q = [&](int lo_, int hi_, int first_, int step_) __attribute__((always_inline)) {   PHASE_LOCALS
            LAS float* scr = (LAS float*)(lds + wave * 16384); LAS float* cm = (LAS float*)(lds + LDSCTL_OFF + 1024);
#define P0_DEC2(item, W, NW_, WT, cix) do { const bool isin_ = (item) >= 352 && (item) < 640; const int ff_ = (item) < 352 ? (item) : (item) - 640 + 352; const int set_ = isin_ ? 0 : ff_ / 176, r_ = isin_ ? 0 : ff_ % 176; const bool isup_ = r_ >= 88; const int lq_ = isin_ ? ((item) - 352) / 72 : 0; \
                const int nb_ = isin_ ? ((item) - 352) % 72 : (isup_ ? r_ - 88 : r_), n0_ = 32 * nb_; NW_ = isin_ ? NIN : DFF; const bool dn_ = set_ < 2; const int si_ = dn_ ? set_ : set_ - 2, pnq_ = n0_ >> 8; \
                const int drow0_ = isin_ ? (pnq_ < 3 ? 256 * pnq_ + 128 * ((n0_ >> 5) & 1) + 32 * ((n0_ >> 6) & 3) : n0_) : 256 * (n0_ >> 7) + (n0_ & 127) + (isup_ ? 128 : 0);     \
                W = (isin_ ? args.in[8] + (size_t)lq_ * D * NIN : (dn_ ? (isup_ ? args.in[18] : args.in[17]) : (isup_ ? args.in[23] : args.in[22])) + (size_t)si_ * D * DFF) + (size_t)(128 * wave) * NW_ + n0_ + 4 * (lane & 7); \
                WT = (isin_ ? (signed char*)(ws + WS_WIN) + (size_t)lq_ * NIN * D : (signed char*)(ws + (dn_ ? WS_DUP : WS_MUP)) + (size_t)si_ * NUP * D) + (size_t)drow0_ * D; cix = (isin_ ? CW_CMAX2 + lq_ * NIN : CW_CMAX + set_ * NUP) + drow0_; } while (0)
#define P0_LOAD2(W, NW_, v) do { _Pragma("unroll") for (int i_ = 0; i_ < 16; ++i_) v[i_] = *(const f32x4*)((W) + (size_t)(8 * i_ + (lane >> 3)) * (NW_)); } while (0)
            const float* WC_; int NWC; signed char* WTC; int cixC; f32x4 qa[16], qb[16];
            int item = lo_ + first_; if (item < hi_) { P0_DEC2(item, WC_, NWC, WTC, cixC); P0_LOAD2(WC_, NWC, qa); }
            for (; item < hi_; item += step_) { const float* WN_ = WC_; int NWN = NWC; signed char* WTN = WTC; int cixN = cixC; const bool hn = item + step_ < hi_;
                if (hn) { P0_DEC2(item + step_, WN_, NWN, WTN, cixN); P0_LOAD2(WN_, NWN, qb); }
                f32x4 m4 = {0.f, 0.f, 0.f, 0.f};
#pragma unroll
                for (int i = 0; i < 16; ++i) { const int kk = 8 * i + (lane >> 3); m4 = __builtin_elementwise_max(m4, __builtin_elementwise_abs(qa[i])); *(LAS f32x4*)(scr + kk * 32 + ((4 * (lane & 7) + 8 * ((kk >> 4) & 3)) & 31)) = qa[i]; }
#pragma unroll
                for (int e = 0; e < 4; ++e) { float m_ = m4[e]; m_ = fmaxf(m_, shx<8>(m_)); m_ = fmaxf(m_, shx<16>(m_)); m4[e] = max32(m_); }
                if (lane < 8) *(LAS f32x4*)(cm + wave * 32 + 4 * lane) = m4;
                __syncthreads();
                const int c = lane & 7;
                if (wave == 0 && lane < 32) { float cx = 0.f;
#pragma unroll
                    for (int w2 = 0; w2 < 8; ++w2) cx = fmaxf(cx, cm[w2 * 32 + lane]);
                    CTL[cixC + lane] = __float_as_uint(cx); }
#pragma unroll
                for (int j = 0; j < 4; ++j) { const int n = (lane >> 3) + 8 * j; float cx = 0.f;
#pragma unroll
                    for (int w2 = 0; w2 < 8; ++w2) cx = fmaxf(cx, cm[w2 * 32 + n]);
                    const float isc = cx > 0.f ? 127.0f / cx : 0.f; const LAS float* sp = scr + (16 * c) * 32 + ((n + 8 * (c & 3)) & 31); unsigned w4[4];
#pragma unroll
                    for (int q = 0; q < 4; ++q) { const int a = (int)rintf(sp[(4 * q) * 32] * isc), b2 = (int)rintf(sp[(4 * q + 1) * 32] * isc), c2 = (int)rintf(sp[(4 * q + 2) * 32] * isc), e2 = (int)rintf(sp[(4 * q + 3) * 32] * isc);
                        w4[q] = (unsigned)(a & 255) | ((unsigned)(b2 & 255) << 8) | ((unsigned)(c2 & 255) << 16) | ((unsigned)(e2 & 255) << 24); }
                    *(u32x4*)(WTC + (size_t)n * D + 128 * wave + 16 * c) = (u32x4){w4[0], w4[1], w4[2], w4[3]}; }
                __syncthreads();
                WC_ = WN_; NWC = NWN; WTC = WTN; cixC = cixN;
#pragma unroll
                for (int i = 0; i < 16; ++i) qa[i] = qb[i]; }
#undef P0_DEC2
#undef P0_LOAD2
    };
    if (IN(0)) {
        PHASE_LOCALS
        {
            LAS float* f8l = (LAS float*)(lds + LDSCTL_OFF + 2048);
            for (int set = wave; set < 22; set += 8) { const bool dn_ = set < 2, wo_ = set >= 18; const int si_ = dn_ ? set : set - 2; float bm[3];
#pragma unroll
                for (int q = 0; q < 3; ++q) { const float* W = wo_ ? args.in[9] + (size_t)(set - 18) * D * D : (q == 0 ? (dn_ ? args.in[17] : args.in[22]) : q == 1 ? (dn_ ? args.in[18] : args.in[23]) : (dn_ ? args.in[19] : args.in[24])) + (size_t)si_ * D * DFF; const int Nq = (q == 2 || wo_) ? D : DFF; float m = 0.f;
#pragma unroll
                    for (int i = 0; i < 8; ++i) { const f32x4 v = *(const f32x4*)(W + (size_t)(8 * i + (lane >> 3)) * Nq + 4 * (lane & 7)); m = fmaxf(m, fmaxf(fmaxf(fabsf(v[0]), fabsf(v[1])), fmaxf(fabsf(v[2]), fabsf(v[3])))); }
                    m = wave_max(m);
                    bm[q] = fmaxf(m, 1e-30f); }
                const float sD = 56.0f / bm[2], sA = wo_ ? SY8 : 8.0f * (3.5f / (32.0f * bm[0])) * (3.5f / (32.0f * bm[1])), dq = 1.0f / (sD * sA);
                if (lane == 0) { f8l[4 * set] = sD; f8l[4 * set + 1] = sA; f8l[4 * set + 2] = dq; if (bx == 0) { TAB[TB_F8 + 4 * set] = sD; TAB[TB_F8 + 4 * set + 1] = sA; TAB[TB_F8 + 4 * set + 2] = dq; } } }
        }
        __syncthreads();
        run_tr(0, 4864, gw, NGW);
        __syncthreads();
        run_q(0, 640 + QPRO, bx, G);
        __syncthreads();
        {   PHASE_LOCALS
            LAS float* Sl = (LAS float*)lds; LAS float* red = (LAS float*)(lds + 17 * 1024 * 4);
            const float* c = args.in[1]; const float* cctx = args.in[3];
            for (int i = tid; i < 17 * 1024; i += 512) { const float x = i < 16384 ? c[i] : cctx[i - 16384]; Sl[i] = x / (1.0f + expf(-x)); }
            __syncthreads();
            for (int item = bx; item < 4 * 96; item += G) {
                const int l = item / 96, cb = item % 96, k0 = wave * 128;
                float acc[17];
#pragma unroll
                for (int b = 0; b < 17; ++b) acc[b] = 0.f;
                const float* w = args.in[4] + ((size_t)l * 1024 + k0) * 6144 + cb * 64 + lane;
#pragma unroll 2
                for (int k = 0; k < 128; k += 4) { const float w0 = w[(size_t)k * 6144], w1 = w[(size_t)(k + 1) * 6144], w2 = w[(size_t)(k + 2) * 6144], w3 = w[(size_t)(k + 3) * 6144];
#pragma unroll
                    for (int b = 0; b < 17; ++b) { const f32x4 s4 = *(const LAS f32x4*)(Sl + b * 1024 + k0 + k); acc[b] += (s4.x * w0 + s4.y * w1) + (s4.z * w2 + s4.w * w3); } }
#pragma unroll
                for (int b = 0; b < 17; ++b) red[(wave * 17 + b) * 64 + lane] = acc[b];
                __syncthreads();
                for (int o = tid; o < 17 * 64; o += 512) { const int b = o >> 6, cl = o & 63; float s = 0.f;
#pragma unroll
                    for (int wv = 0; wv < 8; ++wv) s += red[(wv * 17 + b) * 64 + cl];
                    const int col = cb * 64 + cl, j = col >> 10, cc = col & 1023; float v = s + args.in[5][l * 6144 + col];
                    if (j == 1) v = args.in[6][l * 1024 + cc] * (1.0f + v); if (j == 4) v = args.in[7][l * 1024 + cc] * (1.0f + v);
                    MOD[(((size_t)l * 17 + b) * 6 + j) * 1024 + cc] = v; }
                __syncthreads();
            }
        }
        if (bx < 2) {
            PHASE_LOCALS
            const int t = bx * 512 + tid;
            { const int pos = t >> 4, f = t & 15; const float a = (float)pos * powf(10000.0f, -(float)f / 16.0f); TAB[TB_COSA + t] = cosf(a); TAB[TB_SINA + t] = sinf(a); }
            if (t < 512) { const int pos = t >> 3, f = t & 7; const float a = (float)pos * powf(10000.0f, -(float)f / 8.0f); TAB[TB_COSC + t] = cosf(a); TAB[TB_SINC + t] = sinf(a); }
            if (t < 4) { const float* p = args.in[15] + t * 128; float s1 = 0.f, s2 = 0.f; for (int i = 0; i < 32; ++i) { s1 += p[i] * p[32 + i]; s2 += p[64 + i] * p[96 + i]; }
                const float li = 0.8f - 0.6f * expf(-0.3f * (float)t); TAB[TB_LAM + t] = expf(s1) - expf(s2) + li; TAB[TB_LAM + 4 + t] = 1.0f - li; }
        }
        SEAM(0);
    }
    for (int l = 0; l < DEPTH; ++l) {
        const int pb = PH_L0 + PH_PER_LAYER * l; const bool lastl = l == DEPTH - 1; const int mr = lastl ? ML : MT; const int li = l >> 1;
        const float* MODl = MOD + (size_t)l * 17 * 6144;
        if (IN(pb + PH_NORM1)) {
            PHASE_LOCALS
            NormArgs a{args.in[0], args.in[2], l == 0 ? nullptr : XB, MODl, 1, 0, (bf16*)(ws + WS_H8A), MT, nullptr, nullptr, nullptr, nullptr, nullptr, (float*)(ws + WS_RS), nullptr, (l > 0 && (l & 1) == 0) ? H : nullptr, XB};
            const int rpw = MT / NGW; norm_rows(a, gw * rpw, rpw, lane);
            SEAM(pb + PH_NORM1);
        }
        if (IN(pb + PH_INPROJ)) {
            pg8::InprojSched S{(const char*)(ws + WS_H8A), (const char*)(ws + WS_WIN) + (size_t)l * NIN * D, D / 2, MT / 256, NIN / 256, G, bx, lastl};
            pg8::EpiInprojT<true> E{P, TAB, args.in[10] + l * 64, args.in[11] + l * 64, args.in[12] + l * 32, args.in[13] + l * 32, (const float*)(ws + WS_RS), CTL + CW_CMAX2 + l * NIN};
            pg8::gemm_phase<pg8::EpiInprojT<true>, pg8::InprojSched, true>(lds, S, E, wave_s);
            DEFER_Q((MT / 256) * (NIN / 256), 0, 34);
            SEAM(pb + PH_INPROJ);
        }
        if (IN(pb + PH_ATTN)) {
            static_assert(attn_body::ATTN_LDS_BYTES <= RING_BYTES, "attention LDS");
            char* shm = (char*)lds_raw; unsigned char* const HB = (unsigned char*)H;
            { PHASE_LOCALS const int rpw = mr / NGW; conv_rows(P, HB, args.in[14] + l * 768, gw * rpw, rpw, lane); }
            const float lam = TAB[TB_LAM + l], oml = TAB[TB_LAM + 4 + l]; const float* sub = args.in[16] + l * 64;
#pragma unroll 1
            for (int i = 0; i < 4; ++i) { const int ua = vcu * 4 + i, qb = ua & 7, hq = (ua >> 3) & 7, b = ua >> 6, kv = hq >> 2; const size_t qrow0 = (size_t)b * SEQ + qb * 256, krow0 = (size_t)b * SEQ;
                const long dC = ((long)ML + b * CTX - (long)b * SEQ - SEQ) * NIN;
                attn_body::attn_unit<8, 0>(P + qrow0 * NIN + hq * 64, P + krow0 * NIN + 512 + kv * 64, P + krow0 * NIN + 640 + kv * 64, dC, 32, 36, HB + qrow0 * D + hq * 64, 0.f, 0.f, sub, shm, wave_s); }
#pragma unroll 1
            for (int i = 0; i < 2; ++i) { const int uc = vcu * 2 + i, qb = uc & 7, hd = (uc >> 3) & 3, b = uc >> 5; const size_t qrow0 = (size_t)b * SEQ + qb * 256, krow0 = (size_t)b * SEQ;
                const long dC = ((long)ML + b * CTX - (long)b * SEQ - SEQ) * NIN;
                attn_body::attn_unit<8, 1>(P + qrow0 * NIN + 1536 + hd * 64, P + krow0 * NIN + 1792 + hd * 64, P + krow0 * NIN + 2048 + hd * 64, dC, 32, 36, HB + qrow0 * D + 768 + hd * 64, lam, oml, sub, shm, wave_s);
                attn_body::attn_unit<8, 2>(P + qrow0 * NIN + 1536 + hd * 64 + 32, P + krow0 * NIN + 1792 + hd * 64, P + krow0 * NIN + 2048 + hd * 64, dC, 32, 36, HB + qrow0 * D + 768 + hd * 64, lam, oml, sub, shm, wave_s); }
            if (!lastl) {
                if (vcu < 128) { const int b = vcu >> 3, hq = vcu & 7, kv = hq >> 2; const size_t qrow0 = (size_t)ML + b * CTX;
                    attn_body::attn_unit<8, 0>(P + qrow0 * NIN + hq * 64, P + qrow0 * NIN + 512 + kv * 64, P + qrow0 * NIN + 640 + kv * 64, 0l, 4, 4, HB + qrow0 * D + hq * 64, 0.f, 0.f, sub, shm, wave_s); }
                else if (vcu < 192) { const int j = vcu - 128, b = j >> 2, hd = j & 3; const size_t qrow0 = (size_t)ML + b * CTX;
                    attn_body::attn_unit<8, 1>(P + qrow0 * NIN + 1536 + hd * 64, P + qrow0 * NIN + 1792 + hd * 64, P + qrow0 * NIN + 2048 + hd * 64, 0l, 4, 4, HB + qrow0 * D + 768 + hd * 64, lam, oml, sub, shm, wave_s);
                    attn_body::attn_unit<8, 2>(P + qrow0 * NIN + 1536 + hd * 64 + 32, P + qrow0 * NIN + 1792 + hd * 64, P + qrow0 * NIN + 2048 + hd * 64, 0l, 4, 4, HB + qrow0 * D + 768 + hd * 64, lam, oml, sub, shm, wave_s); }
            }
            SEAM(pb + PH_ATTN);
        }
        if (IN(pb + PH_OUTPROJ)) {
            pg8::DenseSched S{(const char*)H, (const char*)(ws + WS_WOUT) + (size_t)l * D * D, D / 2, mr / 256, D / 256, G, bx};
            pg8::EpiResT<true> E{l == 0 ? args.in[0] : nullptr, args.in[2], XB, MODl, 2, TAB[TB_F8 + 4 * (18 + l) + 2]};
            pg8::gemm_phase<pg8::EpiResT<true>, pg8::DenseSched, true>(lds, S, E, wave_s);
            DEFER_Q((mr / 256) * (D / 256), 34, 71);
            SEAM(pb + PH_OUTPROJ);
        }
        if ((l & 1) == 0) {
            if (IN(pb + PH_NORM2)) {
                PHASE_LOCALS
                NormArgs a{nullptr, nullptr, XB, MODl, 4, 3, H, mr, nullptr, nullptr, nullptr, nullptr, nullptr, (float*)(ws + WS_RS), nullptr, nullptr, nullptr};
                const int rpw = mr / NGW; norm_rows(a, gw * rpw, rpw, lane);
                SEAM(pb + PH_NORM2);
            }
            if (IN(pb + PH_UP0)) {
                pg8::DenseSched S{(const char*)H, (const char*)(ws + WS_DUP) + (size_t)li * NUP * D, D / 2, mr / 256, NUP / 256, G, bx};
                pg8::EpiSwigluI8 E{(unsigned char*)P, DFF, (const float*)(ws + WS_RS), CTL + CW_CMAX + li * NUP, 0, false, TAB + TB_F8, li};
                pg8::gemm_phase<pg8::EpiSwigluI8, pg8::DenseSched, true>(lds, S, E, wave_s);
                DEFER_Q((mr / 256) * (NUP / 256), 71, 100);
                SEAM(pb + PH_UP0);
            }
            if (IN(pb + PH_DN0)) {
                pg8::DenseSched S{(const char*)P, (const char*)(ws + WS_DDN) + (size_t)li * D * DFF, DFF / 2, mr / 256, D / 256, G, bx};
                pg8::EpiResT<true> E{nullptr, nullptr, XB, MODl, 5, TAB[TB_F8 + 4 * li + 2]};
                pg8::gemm_phase<pg8::EpiResT<true>, pg8::DenseSched, true>(lds, S, E, wave_s);
                DEFER_T((mr / 256) * (D / 256));
                SEAM(pb + PH_DN0);
            }
        } else {
            unsigned* cnt = CTL + CW_CNT + 64 * li;
            if (IN(pb + PH_NORM2)) {
                PHASE_LOCALS
                NormArgs a{nullptr, nullptr, XB, MODl, 4, 3, H, mr, args.in[20] + (size_t)li * D * NE, args.in[21] + li * NE, cnt, LIST, GL, (float*)(ws + WS_RS), (float*)(ws + WS_RSL), nullptr, nullptr};
                norm2_router_phase(a, lds, vcu, NGW, tid, lane, wave);
                SEAM(pb + PH_NORM2);
            }
            if (IN(pb + PH_UP0)) {
                pg8::MoeSched<true> S; S.A = (const char*)H; S.Bt = (const char*)(ws + WS_MUP) + (size_t)li * NE * NUP * D; S.estride = (size_t)NUP * D; S.K = D / 2; S.nN = NUP / 256; S.G = G; S.c = bx;
                S.list = LIST; S.init_counts(cnt);
                pg8::EpiSwigluI8 E{(unsigned char*)P, DFF, (const float*)(ws + WS_RSL), CTL + CW_CMAX + (2 + li * NE) * NUP, NUP, true, TAB + TB_F8, 2 + li * NE};
                pg8::gemm_phase<pg8::EpiSwigluI8, pg8::MoeSched<true>, true>(lds, S, E, wave_s);
                { int tp_ = 0;
#pragma unroll
                  for (int j = 0; j < 16; ++j) tp_ += (S.cn[j] + 255) >> 8;
                  DEFER_Q(tp_ * (NUP / 256), 71, 100); }
                SEAM(pb + PH_UP0);
            }
            if (IN(pb + PH_DN0)) {
                pg8::MoeSched<false> S; S.A = (const char*)P; S.Bt = (const char*)(ws + WS_MDN) + (size_t)li * NE * D * DFF; S.estride = (size_t)D * DFF; S.K = DFF / 2; S.nN = D / 256; S.G = G; S.c = bx;
                S.list = LIST; S.init_counts(cnt);
                pg8::EpiMoeDown E{XB, MODl, 5, LIST, GL, H, TAB + TB_F8, 2 + li * NE};
                pg8::gemm_phase<pg8::EpiMoeDown, pg8::MoeSched<false>, true>(lds, S, E, wave_s);
                { int tp_ = 0;
#pragma unroll
                  for (int j = 0; j < 16; ++j) tp_ += (S.cn[j] + 255) >> 8;
                  DEFER_T(tp_ * (D / 256)); }
                SEAM(pb + PH_DN0);
            }
        }
    }
    if (IN(PH_FINAL)) {
        PHASE_LOCALS
        const int rpw = ML / NGW;
        u32x2 xn[4], yn[4];
#pragma unroll
        for (int j = 0; j < 4; ++j) { xn[j] = ((const u32x2*)(XB + (size_t)(gw * rpw) * D))[lane + 64 * j]; yn[j] = ((const u32x2*)(H + (size_t)(gw * rpw) * D))[lane + 64 * j]; }
        for (int i = 0; i < rpw; ++i) { const int row = gw * rpw + i; float* xr = out + (size_t)row * D; u32x2 x[4], y[4];
#pragma unroll
            for (int j = 0; j < 4; ++j) { x[j] = xn[j]; y[j] = yn[j]; }
            if (i + 1 < rpw) {
#pragma unroll
                for (int j = 0; j < 4; ++j) { xn[j] = ((const u32x2*)(XB + (size_t)(row + 1) * D))[lane + 64 * j]; yn[j] = ((const u32x2*)(H + (size_t)(row + 1) * D))[lane + 64 * j]; } }
#pragma unroll
            for (int j = 0; j < 4; ++j) { f32x4 a, c; unpack4(x[j], a); unpack4(y[j], c); *(f32x4*)(xr + 4 * lane + 256 * j) = a + c; } }
    }
#undef IN
#undef SEAM
}
static void launch_mk(const Args& a0, int lo, int hi, int grid, hipStream_t s) { Args a = a0; a.ph_lo = lo; a.ph_hi = hi; a.li = 0; a.pad = 0;
    hipLaunchKernelGGL(mk_fwd, dim3(grid), dim3(512), LDS_BYTES, s, a); }
extern "C" void kernel_launch(void* const* d_in, const int* in_sizes, int n_in, void* d_out, int out_size, void* d_ws, size_t ws_size, hipStream_t stream) {
    static int grid = 0;
    if (grid == 0) {
        if (n_in != 25 || out_size != ML * D || ws_size < WS_END) { fprintf(stderr, "kernel_launch: unexpected shapes (n_in %d out %d ws %zu)\n", n_in, out_size, ws_size); grid = -1; return; }
        int dev = 0, cus = 0, per_cu = 0;
        if (hipGetDevice(&dev) != hipSuccess || hipDeviceGetAttribute(&cus, hipDeviceAttributeMultiprocessorCount, dev) != hipSuccess) { grid = -1; return; }
        if (hipFuncSetAttribute((const void*)mk_fwd, hipFuncAttributeMaxDynamicSharedMemorySize, LDS_BYTES) != hipSuccess) { fprintf(stderr, "kernel_launch: hipFuncSetAttribute failed\n"); grid = -1; return; }
        if (hipOccupancyMaxActiveBlocksPerMultiprocessor(&per_cu, (const void*)mk_fwd, 512, LDS_BYTES) != hipSuccess || per_cu < 1) { fprintf(stderr, "kernel_launch: occupancy query says %d\n", per_cu); }
        (void)hipGetLastError();
        grid = cus;
        if (grid != 256) { fprintf(stderr, "kernel_launch: built for 256 CUs, device has %d\n", cus); grid = -1; return; }
    }
    if (grid < 0) return;
    unsigned char* ws = (unsigned char*)d_ws; float* out = (float*)d_out;
    (void)hipMemsetAsync(ws + WS_CTL, 0, 1 * MiB, stream);
    Args A{}; for (int i = 0; i < 25; ++i) A.in[i] = (const float*)d_in[i]; A.out = out; A.ws = ws;
    launch_mk(A, 0, N_PHASES, grid, stream);
}
```

```cpp
#include <hip/hip_runtime.h>
#include <cstdio>
#include <cstdint>

typedef unsigned short bf16;
typedef float f32x4 __attribute__((ext_vector_type(4)));
typedef unsigned u32x4 __attribute__((ext_vector_type(4)));
typedef unsigned u32x2 __attribute__((ext_vector_type(2)));

constexpr int D = 1024, NB = 16, SEQ = 2048, CTX = 256, ML = NB * SEQ, MC = NB * CTX, MT = ML + MC;
constexpr int NIN = 2304, DFF = 2816, NE = 8, DEPTH = 4;
constexpr float EPS = 1e-6f;
constexpr float LOG2E = 1.4426950408889634f;
constexpr float C2A = 0.125f * LOG2E;
constexpr float C2C = 0.17677669529663687f * LOG2E;

constexpr size_t MiB = 1u << 20;
constexpr size_t WS_CTL = 0;
constexpr size_t WS_MOD = 1 * MiB;
constexpr size_t WS_TAB = 3 * MiB;
constexpr size_t WS_MOE = 4 * MiB;
constexpr size_t WS_XB = 233 * MiB;
constexpr size_t WS_H = 305 * MiB;
constexpr size_t WS_P = 380 * MiB;
constexpr size_t WS_RSL = 377 * MiB;
constexpr size_t WS_END = 798 * MiB;
constexpr int CW_CNT = 64;
constexpr int TB_COSA = 0, TB_SINA = 1024, TB_COSC = 2048, TB_SINC = 2560, TB_LAM = 3072  , TB_F8 = 3200  ;
constexpr size_t MOE_LIST = 0;
constexpr size_t MOE_GATE = (size_t)2 * 8 * MT * 4;

__device__ __forceinline__ float bf2f(unsigned short h) { return __builtin_bit_cast(float, (unsigned)h << 16); }
__device__ __forceinline__ unsigned f2bf(float f) { unsigned u = __builtin_bit_cast(unsigned, f); return (u + 0x7fffu + ((u >> 16) & 1u)) >> 16; }
__device__ __forceinline__ unsigned pk2(float lo, float hi) { return f2bf(lo) | (f2bf(hi) << 16); }
__device__ __forceinline__ int lane_now() { int l; asm volatile("v_mbcnt_lo_u32_b32 %0, -1, 0\n\tv_mbcnt_hi_u32_b32 %0, -1, %0" : "=v"(l)); return l; }
template <int M> __device__ __forceinline__ float shx(float v) {
    return __builtin_bit_cast(float, __builtin_amdgcn_ds_swizzle(__builtin_bit_cast(int, v), (M << 10) | 0x1F)); }
__device__ __forceinline__ void halves32(float v, float& lo, float& hi) {
    float a = v, b = v; asm("s_nop 1\n\tv_permlane32_swap_b32 %0, %1" : "+v"(a), "+v"(b));
    lo = a; hi = b; }
__device__ __forceinline__ float sum32(float v) { float lo, hi; halves32(v, lo, hi); return lo + hi; }
__device__ __forceinline__ float max32(float v) { float lo, hi; halves32(v, lo, hi); return fmaxf(lo, hi); }
template <int CTRL> __device__ __forceinline__ float dppf(float v) { return __builtin_bit_cast(float, __builtin_amdgcn_update_dpp(0, __builtin_bit_cast(int, v), CTRL, 0xF, 0xF, false)); }
__device__ __forceinline__ void halves16(float v, float& ev, float& od) {
    float a = v, b = v; asm("s_nop 1\n\tv_permlane16_swap_b32 %0, %1" : "+v"(a), "+v"(b)); ev = a; od = b; }
__device__ __forceinline__ float wave_sum(float v) { v += dppf<0xB1>(v); v += dppf<0x4E>(v); v += dppf<0x141>(v); v += dppf<0x140>(v); float a, c; halves16(v, a, c); return sum32(a + c); }
__device__ __forceinline__ float wave_max(float v) { v = fmaxf(v, dppf<0xB1>(v)); v = fmaxf(v, dppf<0x4E>(v)); v = fmaxf(v, dppf<0x141>(v)); v = fmaxf(v, dppf<0x140>(v)); float a, c; halves16(v, a, c); return max32(fmaxf(a, c)); }
constexpr float SY8 = 8.0f;
__device__ __forceinline__ u32x2 pack8_fp8(const float (&v)[8], float s) { float t[8];
#pragma unroll
    for (int k = 0; k < 8; ++k) t[k] = __builtin_amdgcn_fmed3f(v[k] * s, -448.0f, 448.0f);
    int w0 = 0, w1 = 0; w0 = __builtin_amdgcn_cvt_pk_fp8_f32(t[0], t[1], w0, false); w0 = __builtin_amdgcn_cvt_pk_fp8_f32(t[2], t[3], w0, true); w1 = __builtin_amdgcn_cvt_pk_fp8_f32(t[4], t[5], w1, false); w1 = __builtin_amdgcn_cvt_pk_fp8_f32(t[6], t[7], w1, true);
    return (u32x2){(unsigned)w0, (unsigned)w1}; }
__device__ __forceinline__ void unpack8(u32x4 w, float (&v)[8]) {
    v[0] = bf2f(w.x & 0xffff); v[1] = bf2f(w.x >> 16); v[2] = bf2f(w.y & 0xffff); v[3] = bf2f(w.y >> 16);
    v[4] = bf2f(w.z & 0xffff); v[5] = bf2f(w.z >> 16); v[6] = bf2f(w.w & 0xffff); v[7] = bf2f(w.w >> 16);
}
__device__ __forceinline__ u32x4 pack8(const float (&v)[8]) { u32x4 w; w.x = pk2(v[0], v[1]); w.y = pk2(v[2], v[3]); w.z = pk2(v[4], v[5]); w.w = pk2(v[6], v[7]); return w; }

struct NormArgs { const float* XL; const float* XC; const bf16* XB; const float* MODl; int jA, jS; bf16* H; int nrows;
                  const float* rw; const float* rb; unsigned* cnt; int* list; float* glist; float* rs8; float* rsl; const bf16* y1; bf16* WB; };
__device__ __forceinline__ float write_row_i8(const f32x4 (&v)[4], signed char* H8row, float* rs, int lane) {
    float am = 0.f;
#pragma unroll
    for (int j = 0; j < 4; ++j) am = fmaxf(fmaxf(am, fmaxf(fabsf(v[j].x), fabsf(v[j].y))), fmaxf(fabsf(v[j].z), fabsf(v[j].w)));
    am = wave_max(am);
    const float isc = am > 0.f ? 127.0f / am : 0.f; if (lane == 0) *rs = am * (1.0f / 127.0f);
#pragma unroll
    for (int j = 0; j < 4; ++j) { const int a = (int)rintf(v[j].x * isc), b = (int)rintf(v[j].y * isc), c = (int)rintf(v[j].z * isc), e = (int)rintf(v[j].w * isc);
        ((unsigned*)H8row)[lane + 64 * j] = (unsigned)(a & 255) | ((unsigned)(b & 255) << 8) | ((unsigned)(c & 255) << 16) | ((unsigned)(e & 255) << 24); }
    return am * (1.0f / 127.0f);
}
struct NormRow { f32x4 v[4]; u32x2 xb[4]; u32x2 y[4]; f32x4 av[4], sv[4]; };
__device__ __forceinline__ void unpack4(u32x2 w, f32x4& v) { v.x = bf2f(w.x & 0xffff); v.y = bf2f(w.x >> 16); v.z = bf2f(w.y & 0xffff); v.w = bf2f(w.y >> 16); }
__device__ __forceinline__ void norm_load(const NormArgs& a, int row, int lane, NormRow& r) {
    if (a.XB) { const u32x2* xr = (const u32x2*)(a.XB + (size_t)row * D);
#pragma unroll
        for (int j = 0; j < 4; ++j) r.xb[j] = xr[lane + 64 * j]; }
    else { const float* xr = row < ML ? a.XL + (size_t)row * D : a.XC + (size_t)(row - ML) * D;
#pragma unroll
        for (int j = 0; j < 4; ++j) r.v[j] = *(const f32x4*)(xr + 4 * lane + 256 * j); }
    if (a.y1) { const u32x2* yr = (const u32x2*)(a.y1 + (size_t)row * D);
#pragma unroll
        for (int j = 0; j < 4; ++j) r.y[j] = yr[lane + 64 * j]; }
    { const int b = row < ML ? row >> 11 : 16; const float* A = a.MODl + ((size_t)b * 6 + a.jA) * 1024; const float* S = a.MODl + ((size_t)b * 6 + a.jS) * 1024;
#pragma unroll
      for (int j = 0; j < 4; ++j) { r.av[j] = *(const f32x4*)(A + 4 * lane + 256 * j); r.sv[j] = *(const f32x4*)(S + 4 * lane + 256 * j); } }
}
__device__ __forceinline__ void norm_finish(const NormArgs& a, int row, int lane, NormRow& r) {
    f32x4 (&v)[4] = r.v; float ss = 0.f;
    if (a.XB) {
#pragma unroll
        for (int j = 0; j < 4; ++j) unpack4(r.xb[j], v[j]); }
    if (a.y1) { u32x2* xw = (u32x2*)(a.WB + (size_t)row * D);
#pragma unroll
        for (int j = 0; j < 4; ++j) { f32x4 y; unpack4(r.y[j], y); v[j] = v[j] + y; u32x2 w; w.x = pk2(v[j].x, v[j].y); w.y = pk2(v[j].z, v[j].w); xw[lane + 64 * j] = w; unpack4(w, v[j]); } }
#pragma unroll
    for (int j = 0; j < 4; ++j) ss += (v[j].x * v[j].x + v[j].y * v[j].y) + (v[j].z * v[j].z + v[j].w * v[j].w);
    const float rstd = rsqrtf(wave_sum(ss) * (1.0f / D) + EPS);
#pragma unroll
    for (int j = 0; j < 4; ++j) v[j] = v[j] * rstd * r.av[j] + r.sv[j];
    if (a.rs8) { write_row_i8(v, (signed char*)a.H + (size_t)row * D, a.rs8 + row, lane); return; }
    u32x2* o = (u32x2*)(a.H + (size_t)row * D);
#pragma unroll
    for (int j = 0; j < 4; ++j) { u32x2 w; w.x = pk2(v[j].x, v[j].y); w.y = pk2(v[j].z, v[j].w); o[lane + 64 * j] = w; }
}
__device__ __forceinline__ void norm_rows(const NormArgs& a, int r0, int n, int lane) {
    NormRow ra, rb; norm_load(a, r0, lane, ra);
    for (int i = 0; i < n; i += 2) {
        norm_load(a, r0 + i + 1, lane, rb); norm_finish(a, r0 + i, lane, ra);
        if (i + 2 < n) norm_load(a, r0 + i + 2, lane, ra);
        norm_finish(a, r0 + i + 1, lane, rb); }
}
constexpr size_t WS_WIN = 9 * MiB, WS_WOUT = 27 * MiB, WS_DUP = 35 * MiB, WS_DDN = 46 * MiB, WS_MUP = 57 * MiB, WS_MDN = 145 * MiB;
static_assert(WS_MDN + 88 * MiB <= WS_XB && WS_XB + 72 * MiB <= WS_H && WS_MOE + 2 * MOE_GATE <= WS_WIN && WS_RSL + 3 * MiB <= WS_P && WS_H + 72 * MiB <= WS_RSL && WS_P + 418 * MiB <= WS_END, "ws map");
constexpr int NUP = 2 * DFF;
constexpr int CW_BAR = 4096;

#define LAS __attribute__((address_space(3)))
#define GAS __attribute__((address_space(1)))
typedef short bf16x8 __attribute__((ext_vector_type(8)));
typedef GAS unsigned gu32;
#define RLX_AGENT __ATOMIC_RELAXED, __HIP_MEMORY_SCOPE_AGENT

namespace pg8 {
constexpr int BM = 256, BK = 64, HALF = 128, HTB = HALF * BK * 2, STAGE_BYTES = 8 * HTB, NXCD = 8, WGM = 8;
__host__ __device__ __forceinline__ int lds_byte(int r, int c) { const int st = (r >> 4) * 2 + (c >> 5), rr = r & 15, cc = c & 31, ob = rr * 64 + cc * 2; return st * 1024 + (ob ^ (((ob >> 9) & 1) << 5)); }
__host__ __device__ __forceinline__ void stage_rc(int b, int& R, int& C) { const int st = b / 1024, sb = b % 1024, swz = sb ^ (((sb >> 9) & 1) << 5); R = (st >> 1) * 16 + swz / 64; C = (st & 1) * 32 + (swz % 64) / 2; }
__host__ __device__ __forceinline__ int perm32(int rho) { const int n = rho >> 4, i = rho & 15; return 8 * (i >> 2) + 4 * n + (i & 3); }

struct Unit { int pm, pn, e, row0, nval; };

__device__ __forceinline__ bool order_unit(long L, int nM, int nN, int& pm, int& pn) {
    const int nwg = nM * nN; if (L >= nwg) return false;
    int wgid = (int)L; { const int q = nwg / NXCD, r = nwg % NXCD, xcd = wgid % NXCD, off = wgid / NXCD; wgid = (xcd < r ? xcd * (q + 1) : r * (q + 1) + (xcd - r) * q) + off; }
    const int nig = WGM * nN, gid = wgid / nig, fm = gid * WGM, gsz = (nM - fm) < WGM ? (nM - fm) : WGM;
    pm = fm + ((wgid % nig) % gsz); pn = (wgid % nig) / gsz; return true;
}
__device__ __forceinline__ bool order_next(int i, int nM, int nN, int G, int c, int& pm, int& pn) { return order_unit((long)i * G + c, nM, nN, pm, pn); }
struct DenseSched {
    static constexpr bool GATHER = false;
    const char* A; const char* Bt; int K, nM, nN, G, c;
    __device__ __forceinline__ bool next(int i, Unit& u) const { u.e = 0; u.row0 = 0; u.nval = 256; return order_next(i, nM, nN, G, c, u.pm, u.pn); }
    __device__ __forceinline__ const char* a_tile(const Unit& u) const { return A + (size_t)u.pm * 256 * K * 2; }
    __device__ __forceinline__ const char* b_tile(const Unit& u) const { return Bt + (size_t)u.pn * 256 * K * 2; }
    __device__ __forceinline__ unsigned arow_off(const Unit&, int r) const { return (unsigned)(r * K * 2); }
};
struct InprojSched {
    static constexpr bool GATHER = false;
    const char* A; const char* Bt; int K, nM, nN, G, c; bool lastl;
    __device__ __forceinline__ bool next(int i, Unit& u) const { u.e = 0; u.row0 = 0; u.nval = 256;
        if (!lastl) return order_next(i, nM, nN, G, c, u.pm, u.pn);
        const long L = (long)i * G + c; constexpr int NLAT = (ML / 256) * (NIN / 256);
        if (L < NLAT) return order_unit(L, ML / 256, NIN / 256, u.pm, u.pn);
        const int idx = (int)(L - NLAT); if (idx >= 3 * (MC / 256)) return false;
        const int r = idx % 3; u.pm = ML / 256 + idx / 3; u.pn = r == 0 ? 2 : 6 + r; return true; }
    __device__ __forceinline__ const char* a_tile(const Unit& u) const { return A + (size_t)u.pm * 256 * K * 2; }
    __device__ __forceinline__ const char* b_tile(const Unit& u) const { return Bt + (size_t)u.pn * 256 * K * 2; }
    __device__ __forceinline__ unsigned arow_off(const Unit&, int r) const { return (unsigned)(r * K * 2); }
};
template <bool GATH> struct MoeSched {
    static constexpr bool GATHER = GATH;
    const char* A; const char* Bt; size_t estride; int K, nN, G, c; const int* list; int cn[16];
    __device__ __forceinline__ void init_counts(const unsigned* cnt) {
#pragma unroll
        for (int j = 0; j < 16; ++j) cn[j] = (int)cnt[j]; }
    __device__ __forceinline__ bool next(int i, Unit& u) const {
        int tot = 0;
#pragma unroll
        for (int j = 0; j < 16; ++j) tot += (cn[j] + 255) >> 8;
        int vp, pn; if (!order_next(i, tot, nN, G, c, vp, pn)) return false;
        int e = 0, pb = 0, ce = cn[0], p = (cn[0] + 255) >> 8;
#pragma unroll
        for (int j = 1; j < 16; ++j) { const int jj = ((j & 1) << 3) | (j >> 1); if (vp >= p) { e = jj; pb = p; ce = cn[jj]; } p += (cn[jj] + 255) >> 8; }
        u.pm = vp; u.pn = pn; u.e = e; u.row0 = 256 * (vp - pb); u.nval = ce - u.row0; return true;
    }
    __device__ __forceinline__ const char* a_tile(const Unit& u) const { return GATH ? A : A + (size_t)u.pm * 256 * K * 2; }
    __device__ __forceinline__ const char* b_tile(const Unit& u) const { return Bt + (size_t)(u.e & 7) * estride + (size_t)u.pn * 256 * K * 2; }
    __device__ __forceinline__ unsigned arow_off(const Unit& u, int r) const {
        if constexpr (GATH) { const int rr = r < u.nval ? r : u.nval - 1; return (unsigned)list[(size_t)u.e * MT + u.row0 + rr] * (unsigned)(K * 2); }
        else return (unsigned)(r * K * 2);
    }
};

typedef int i32x4 __attribute__((ext_vector_type(4))); typedef int i32x8 __attribute__((ext_vector_type(8)));
template <bool I8> struct AccT { typedef f32x4 type; }; template <> struct AccT<true> { typedef i32x4 type; };
__device__ __forceinline__ f32x4 acc_f32(const f32x4& a) { return a; }
__device__ __forceinline__ f32x4 acc_f32(const i32x4& a) { return (f32x4){(float)a[0], (float)a[1], (float)a[2], (float)a[3]}; }
typedef float f32x2_e __attribute__((ext_vector_type(2))); typedef __bf16 bf16x2_e __attribute__((ext_vector_type(2)));
__device__ __forceinline__ unsigned cvt_pk_bf16(float lo, float hi) { const f32x2_e v = {lo, hi}; const bf16x2_e b = __builtin_convertvector(v, bf16x2_e); return __builtin_bit_cast(unsigned, b); }
template <bool I8_> struct EpiInprojT {
    static constexpr bool PERM = true, I8 = I8_, F8 = false; typedef typename AccT<I8_>::type acc_t;
    bf16* O; const float* TAB; const float* aqg; const float* akg; const float* dqg; const float* dkg; const float* rs; const unsigned* cmax;
    __device__ __forceinline__ void operator()(acc_t (&acc)[2][2][4][2], const Unit& u, int wr, int wc, int fr_, int fq_) const {
        int fr = fr_, fq = fq_; asm volatile("" : "+v"(fr), "+v"(fq));
        const int pn = u.pn; const bool lat = u.pm < ML / BM; const int row0 = u.pm * BM + wr * 64 + fr;
        if constexpr (I8_) {
            float rsv[2][4];
#pragma unroll
            for (int ai = 0; ai < 2; ++ai)
#pragma unroll
                for (int m = 0; m < 4; ++m) rsv[ai][m] = rs[row0 + ai * HALF + m * 16];
#pragma unroll
            for (int bj = 0; bj < 2; ++bj)
#pragma unroll
                for (int n = 0; n < 2; ++n) { const u32x4 a = *(const u32x4*)(cmax + 256 * pn + HALF * bj + 32 * wc + 8 * fq + 4 * n); const f32x4 csv = (f32x4){__uint_as_float(a.x), __uint_as_float(a.y), __uint_as_float(a.z), __uint_as_float(a.w)} * (1.0f / 127.0f);
#pragma unroll
                    for (int ai = 0; ai < 2; ++ai)
#pragma unroll
                        for (int m = 0; m < 4; ++m) acc[ai][bj][m][n] = __builtin_bit_cast(acc_t, acc_f32(acc[ai][bj][m][n]) * (csv * rsv[ai][m])); }
        }
#define XV(ai, bj, m, n) __builtin_bit_cast(f32x4, acc[ai][bj][m][n])
        if (pn < 3 && !(pn == 2 && wc >= 2)) {
            const float* gp = (pn < 2 ? aqg : akg) + 8 * fq; const float sc = pn < 2 ? C2A : 1.0f; const int f0 = 8 * (fq & 1); const bool isx2 = fq >= 2;
            f32x4 g[2][2];
#pragma unroll
            for (int bj = 0; bj < 2; ++bj)
#pragma unroll
                for (int n = 0; n < 2; ++n) g[bj][n] = *(const f32x4*)(gp + 32 * bj + 4 * n);
            f32x4 cr[2][2], sr[2][2];
#pragma unroll
            for (int ai = 0; ai < 2; ++ai) { const int prow = lat ? (4 * u.pm + 2 * ai + wr) & 31 : 0;
#pragma unroll
                for (int n = 0; n < 2; ++n) { cr[ai][n] = *(const f32x4*)(TAB + TB_COSA + prow * 16 + f0 + 4 * n); sr[ai][n] = *(const f32x4*)(TAB + TB_SINA + prow * 16 + f0 + 4 * n); } }
            const float csc = sc, ssc = isx2 ? sc : -sc;
            const int paddr = ((((fq ^ 2) << 4) | fr) << 2);
#pragma unroll
            for (int ai = 0; ai < 2; ++ai)
#pragma unroll
                for (int n = 0; n < 2; ++n) { cr[ai][n] = cr[ai][n] * csc; sr[ai][n] = sr[ai][n] * ssc; }
#pragma unroll
            for (int mh = 0; mh < 4; ++mh) { f32x4 cc[1][2], sn[1][2];
#pragma unroll
                for (int mi = 0; mi < 1; ++mi) { const int pcol = lat ? 16 * (mh + mi) + fr : 0;
#pragma unroll
                    for (int n = 0; n < 2; ++n) { cc[mi][n] = *(const f32x4*)(TAB + TB_COSA + pcol * 16 + f0 + 4 * n) * csc; sn[mi][n] = *(const f32x4*)(TAB + TB_SINA + pcol * 16 + f0 + 4 * n) * ssc; } }
#pragma unroll
                for (int mi = 0; mi < 1; ++mi)
#pragma unroll
                    for (int ai = 0; ai < 2; ++ai) { const int m = mh + mi;
                    float ss = 0.f;
#pragma unroll
                    for (int bj = 0; bj < 2; ++bj)
#pragma unroll
                        for (int n = 0; n < 2; ++n) { const f32x4 x = XV(ai, bj, m, n); ss += (x[0] * x[0] + x[1] * x[1]) + (x[2] * x[2] + x[3] * x[3]); }
                    ss += shx<16>(ss); ss = sum32(ss);
                    const float rstd = rsqrtf(ss * (1.0f / 64.0f) + EPS);
                    bf16* rowp = O + (size_t)(row0 + ai * HALF + m * 16) * NIN + 256 * pn + 64 * wc + 8 * fq;
#pragma unroll
                    for (int bj = 0; bj < 2; ++bj) { float o[8];
#pragma unroll
                        for (int n = 0; n < 2; ++n) { const f32x4 xq = XV(ai, bj, m, n) * (g[bj][n] * rstd);
#pragma unroll
                            for (int e = 0; e < 4; ++e) { const float xv = xq[e]; const float p = __builtin_bit_cast(float, __builtin_amdgcn_ds_bpermute(paddr, __builtin_bit_cast(int, xv)));
                                const float cs_ = bj ? cc[mi][n][e] : cr[ai][n][e], sv = bj ? sn[mi][n][e] : sr[ai][n][e];
                                o[4 * n + e] = xv * cs_ + p * sv; } }
                        u32x4 w; w.x = cvt_pk_bf16(o[0], o[1]); w.y = cvt_pk_bf16(o[2], o[3]); w.z = cvt_pk_bf16(o[4], o[5]); w.w = cvt_pk_bf16(o[6], o[7]);
                        *(u32x4*)(rowp + 32 * bj) = w; } } }
        } else if (pn == 6 || pn == 7) {
            const float* gp = (pn == 6 ? dqg : dkg) + 8 * fq; const float sc = pn == 6 ? C2C : 1.0f; const bool isx2 = (fq & 1) != 0;
            f32x4 g[2];
#pragma unroll
            for (int n = 0; n < 2; ++n) g[n] = *(const f32x4*)(gp + 4 * n);
            const float csc = sc, ssc = isx2 ? sc : -sc;
#pragma unroll
            for (int mh = 0; mh < 4; ++mh) { f32x4 cs2[1][2][2], sv[1][2][2];
#pragma unroll
                for (int mi = 0; mi < 1; ++mi)
#pragma unroll
                    for (int ai = 0; ai < 2; ++ai) { const int prow = (4 * u.pm + 2 * ai + wr) & 31; const int pos = lat ? (fq >= 2 ? 16 * (mh + mi) + fr : prow) : 0;
#pragma unroll
                        for (int n = 0; n < 2; ++n) { cs2[mi][ai][n] = *(const f32x4*)(TAB + TB_COSC + pos * 8 + 4 * n) * csc; sv[mi][ai][n] = *(const f32x4*)(TAB + TB_SINC + pos * 8 + 4 * n) * ssc; } }
#pragma unroll
                for (int mi = 0; mi < 1; ++mi)
#pragma unroll
                    for (int ai = 0; ai < 2; ++ai) { const int m = mh + mi;
                    bf16* rowp = O + (size_t)(row0 + ai * HALF + m * 16) * NIN + 256 * pn + 32 * wc + 8 * fq;
#pragma unroll
                    for (int bj = 0; bj < 2; ++bj) { float ss = 0.f;
#pragma unroll
                        for (int n = 0; n < 2; ++n) { const f32x4 x = XV(ai, bj, m, n); ss += (x[0] * x[0] + x[1] * x[1]) + (x[2] * x[2] + x[3] * x[3]); }
                        ss += shx<16>(ss); ss = sum32(ss);
                        const float rstd = rsqrtf(ss * (1.0f / 32.0f) + EPS); float o[8];
#pragma unroll
                        for (int n = 0; n < 2; ++n) { const f32x4 xq = XV(ai, bj, m, n) * (g[n] * rstd);
#pragma unroll
                            for (int e = 0; e < 4; ++e) { const float xv = xq[e]; const float p = shx<16>(xv);
                                o[4 * n + e] = xv * cs2[mi][ai][n][e] + p * sv[mi][ai][n][e]; } }
                        u32x4 w; w.x = cvt_pk_bf16(o[0], o[1]); w.y = cvt_pk_bf16(o[2], o[3]); w.z = cvt_pk_bf16(o[4], o[5]); w.w = cvt_pk_bf16(o[6], o[7]);
                        *(u32x4*)(rowp + HALF * bj) = w; } } }
        } else {
            const int colb = pn < 3 ? 256 * pn + 64 * wc + 8 * fq : 256 * pn + 32 * wc + 8 * fq; const int bjs = pn < 3 ? 32 : HALF;
#pragma unroll
            for (int ai = 0; ai < 2; ++ai)
#pragma unroll
                for (int m = 0; m < 4; ++m) { bf16* rowp = O + (size_t)(row0 + ai * HALF + m * 16) * NIN + colb;
#pragma unroll
                    for (int bj = 0; bj < 2; ++bj) { const f32x4 v0 = XV(ai, bj, m, 0), v1 = XV(ai, bj, m, 1); u32x4 w; w.x = cvt_pk_bf16(v0[0], v0[1]); w.y = cvt_pk_bf16(v0[2], v0[3]); w.z = cvt_pk_bf16(v1[0], v1[1]); w.w = cvt_pk_bf16(v1[2], v1[3]);
                        *(u32x4*)(rowp + bjs * bj) = w; } }
        }
#undef XV
    }
};
__device__ __forceinline__ float silu_mul(float g, float u) { return g * __builtin_amdgcn_rcpf(1.0f + __builtin_amdgcn_exp2f(-LOG2E * g)) * u; }
struct EpiSwigluI8 {
    static constexpr bool PERM = true, I8 = true, F8 = false; unsigned char* O; int ldc; const float* rs; const unsigned* cmax0; int cstride; bool gath; const float* f8tab; int set0;
    __device__ __forceinline__ void operator()(const i32x4 (&acc)[2][2][4][2], const Unit& u, int wr, int wc, int fr, int fq) const {
        const int row0 = u.pm * BM + wr * 64 + fr, col0 = u.pn * HALF + wc * 32 + 8 * fq, brow0 = u.pn * BM + wc * 32 + 8 * fq; const unsigned* cmax = cmax0 + (u.e & 7) * cstride;
        const float sa = f8tab[4 * (set0 + (gath ? (u.e & 7) : 0)) + 1];
        f32x4 cA[2], cB[2];
#pragma unroll
        for (int n = 0; n < 2; ++n) { const u32x4 a = *(const u32x4*)(cmax + brow0 + 4 * n), b = *(const u32x4*)(cmax + brow0 + HALF + 4 * n);
            const f32x4 cg = (f32x4){__uint_as_float(a.x), __uint_as_float(a.y), __uint_as_float(a.z), __uint_as_float(a.w)} * (1.0f / 127.0f), cu = (f32x4){__uint_as_float(b.x), __uint_as_float(b.y), __uint_as_float(b.z), __uint_as_float(b.w)} * (1.0f / 127.0f);
            cA[n] = cg * (-LOG2E); cB[n] = cg * cu * sa; }
        float rsa[2][4];
#pragma unroll
        for (int ai = 0; ai < 2; ++ai)
#pragma unroll
            for (int m = 0; m < 4; ++m) { const int rr = ai * HALF + wr * 64 + m * 16 + fr; if (gath) { const int r2 = rr < u.nval ? rr : u.nval - 1; rsa[ai][m] = rs[(size_t)u.e * MT + u.row0 + r2]; } else rsa[ai][m] = rs[u.pm * BM + rr]; }
#pragma unroll
        for (int ai = 0; ai < 2; ++ai)
#pragma unroll
            for (int m = 0; m < 4; ++m) { unsigned char* rowp = O + (size_t)(row0 + ai * HALF + m * 16) * ldc + col0; const float rsv = rsa[ai][m], rs2 = rsv * rsv;
                f32x4 o[2];
#pragma unroll
                for (int n = 0; n < 2; ++n)
#pragma unroll
                    for (int h = 0; h < 2; ++h) { typedef float f32x2 __attribute__((ext_vector_type(2)));
                        const f32x2 G = {(float)acc[ai][0][m][n][2 * h], (float)acc[ai][0][m][n][2 * h + 1]}, U = {(float)acc[ai][1][m][n][2 * h], (float)acc[ai][1][m][n][2 * h + 1]};
                        const f32x2 ca = {cA[n][2 * h], cA[n][2 * h + 1]}, cb = {cB[n][2 * h], cB[n][2 * h + 1]};
                        const f32x2 t = G * (ca * rsv); const f32x2 d = (f32x2){__builtin_amdgcn_exp2f(t[0]), __builtin_amdgcn_exp2f(t[1])} + 1.0f;
                        const f32x2 r = {__builtin_amdgcn_rcpf(d[0]), __builtin_amdgcn_rcpf(d[1])};
                        const f32x2 x = (G * U) * (cb * rs2) * r;
                        o[n][2 * h] = __builtin_amdgcn_fmed3f(x[0], -448.0f, 448.0f); o[n][2 * h + 1] = __builtin_amdgcn_fmed3f(x[1], -448.0f, 448.0f); }
                int w0 = 0, w1 = 0; w0 = __builtin_amdgcn_cvt_pk_fp8_f32(o[0][0], o[0][1], w0, false); w0 = __builtin_amdgcn_cvt_pk_fp8_f32(o[0][2], o[0][3], w0, true); w1 = __builtin_amdgcn_cvt_pk_fp8_f32(o[1][0], o[1][1], w1, false); w1 = __builtin_amdgcn_cvt_pk_fp8_f32(o[1][2], o[1][3], w1, true);
                *(u32x2*)rowp = (u32x2){(unsigned)w0, (unsigned)w1}; }
    }
};
__device__ __forceinline__ void unpack8f(u32x4 w, f32x4& lo, f32x4& hi) { lo = (f32x4){bf2f(w.x & 0xffff), bf2f(w.x >> 16), bf2f(w.y & 0xffff), bf2f(w.y >> 16)}; hi = (f32x4){bf2f(w.z & 0xffff), bf2f(w.z >> 16), bf2f(w.w & 0xffff), bf2f(w.w >> 16)}; }
__device__ __forceinline__ u32x4 pack8f(f32x4 lo, f32x4 hi) { u32x4 w; w.x = cvt_pk_bf16(lo[0], lo[1]); w.y = cvt_pk_bf16(lo[2], lo[3]); w.z = cvt_pk_bf16(hi[0], hi[1]); w.w = cvt_pk_bf16(hi[2], hi[3]); return w; }
template <bool F8_> struct EpiResT {
    static constexpr bool PERM = true, I8 = false, F8 = F8_; const float* baseL; const float* baseC; bf16* XB; const float* MODl; int jG; float dq;
    __device__ __forceinline__ void operator()(const f32x4 (&acc)[2][2][4][2], const Unit& u, int wr, int wc, int fr, int fq) const {
        if constexpr (F8_) { const int t_ = lane_now(); fr = t_ & 15; fq = t_ >> 4; }
        const bool lat = u.pm < ML / BM; const int b = lat ? u.pm >> 3 : 16; const int row0 = u.pm * BM + wr * 64 + fr, col0 = u.pn * BM + wc * 32 + 8 * fq;
        const float* gp = MODl + ((size_t)b * 6 + jG) * 1024 + col0; f32x4 gt[2][2];
#pragma unroll
        for (int bj = 0; bj < 2; ++bj)
#pragma unroll
            for (int n = 0; n < 2; ++n) gt[bj][n] = *(const f32x4*)(gp + bj * HALF + 4 * n) * dq;
        if (baseL) {
            const float* bp = lat ? baseL + (size_t)row0 * D + col0 : baseC + (size_t)(row0 - ML) * D + col0;
#pragma unroll
            for (int ai = 0; ai < 2; ++ai) { f32x4 bs[4][2][2];
#pragma unroll
                for (int m = 0; m < 4; ++m)
#pragma unroll
                    for (int bj = 0; bj < 2; ++bj)
#pragma unroll
                        for (int n = 0; n < 2; ++n) bs[m][bj][n] = *(const f32x4*)(bp + (size_t)(ai * HALF + m * 16) * D + bj * HALF + 4 * n);
#pragma unroll
                for (int m = 0; m < 4; ++m)
#pragma unroll
                    for (int bj = 0; bj < 2; ++bj) *(u32x4*)(XB + (size_t)(row0 + ai * HALF + m * 16) * D + col0 + bj * HALF) = pack8f(bs[m][bj][0] + gt[bj][0] * acc[ai][bj][m][0], bs[m][bj][1] + gt[bj][1] * acc[ai][bj][m][1]);
                asm volatile("" ::: "memory"); }
        } else {
            u32x4 bs[2][4][2];
#pragma unroll
            for (int ai = 0; ai < 2; ++ai)
#pragma unroll
                for (int m = 0; m < 4; ++m)
#pragma unroll
                    for (int bj = 0; bj < 2; ++bj) bs[ai][m][bj] = *(const u32x4*)(XB + (size_t)(row0 + ai * HALF + m * 16) * D + col0 + bj * HALF);
#pragma unroll
            for (int ai = 0; ai < 2; ++ai)
#pragma unroll
                for (int m = 0; m < 4; ++m)
#pragma unroll
                    for (int bj = 0; bj < 2; ++bj) { f32x4 lo, hi; unpack8f(bs[ai][m][bj], lo, hi);
                        *(u32x4*)(XB + (size_t)(row0 + ai * HALF + m * 16) * D + col0 + bj * HALF) = pack8f(lo + gt[bj][0] * acc[ai][bj][m][0], hi + gt[bj][1] * acc[ai][bj][m][1]); }
        }
    }
};
struct EpiMoeDown {
    static constexpr bool PERM = true, I8 = false, F8 = true; bf16* XB; const float* MODl; int jG; const int* list; const float* glist; bf16* Y1; const float* f8tab; int set0;
    __device__ __forceinline__ void operator()(const f32x4 (&acc)[2][2][4][2], const Unit& u, int wr, int wc, int fr, int fq) const {
        { const int t_ = lane_now(); fr = t_ & 15; fq = t_ >> 4; }
        const int col0 = u.pn * BM + wc * 32 + 8 * fq; const bool r1 = u.e >= 8; const float dq = f8tab[4 * (set0 + (u.e & 7)) + 2];
        int tok[2][4]; float gw[2][4];
#pragma unroll
        for (int ai = 0; ai < 2; ++ai)
#pragma unroll
            for (int m = 0; m < 4; ++m) { const int rr = ai * HALF + wr * 64 + m * 16 + fr; const bool ok = rr < u.nval; const size_t li = (size_t)u.e * MT + u.row0 + (ok ? rr : 0);
                tok[ai][m] = ok ? list[li] : -1; gw[ai][m] = glist[li] * dq; }
#pragma unroll
        for (int ai = 0; ai < 2; ++ai) { u32x4 bs[4][2];
#pragma unroll
            for (int m = 0; m < 4; ++m) { const int tk = tok[ai][m]; const int tq = tk >= 0 ? tk : 0;
#pragma unroll
                for (int bj = 0; bj < 2; ++bj) bs[m][bj] = r1 ? (u32x4){0, 0, 0, 0} : *(const u32x4*)(XB + (size_t)tq * D + col0 + bj * HALF); }
#pragma unroll
            for (int m = 0; m < 4; ++m) { const int tk = tok[ai][m];
                if (tk >= 0) { const int b = tk < ML ? tk >> 11 : 16; const float g = gw[ai][m]; const float* gp = MODl + ((size_t)b * 6 + jG) * 1024 + col0; bf16* op = (r1 ? Y1 : XB) + (size_t)tk * D + col0;
#pragma unroll
                    for (int bj = 0; bj < 2; ++bj) { const f32x4 g0 = *(const f32x4*)(gp + bj * HALF), g1 = *(const f32x4*)(gp + bj * HALF + 4); f32x4 lo, hi; unpack8f(bs[m][bj], lo, hi);
                        *(u32x4*)(op + bj * HALF) = pack8f(lo + g0 * g * acc[ai][bj][m][0], hi + g1 * g * acc[ai][bj][m][1]); } } }
            asm volatile("" ::: "memory"); }
    }
};

template <class Epi, class Sched, bool ALIGN_EPI>
__device__ __forceinline__ void gemm_phase(LAS unsigned char* lds, const Sched& S, const Epi& E, int wv) {
    const int tid_ = wv * 64 + lane_now();
    const int tid = tid_, wid = __builtin_amdgcn_readfirstlane(tid >> 6), lane = tid & 63, wr = wid >> 2, wc = wid & 3, fr = lane & 15, fq = lane >> 4;
    const int K = S.K, nt = K / BK;
    unsigned voffB[2];
#pragma unroll
    for (int i = 0; i < 2; ++i) { int R, C; stage_rc(tid * 16 + i * 8192, R, C); const int Rb = Epi::PERM ? ((R & ~31) + perm32(R & 31)) : R; voffB[i] = (unsigned)(Rb * K + C) * 2u; }
    const size_t kstep = (size_t)(BK * 2);
    const size_t hstep = (size_t)HALF * K * 2;
    const unsigned ldsw = (unsigned)wid * 1024u;
    const int aoff = lds_byte(wr * 64 + fr, fq * 8), boff = lds_byte(wc * 32 + fr, fq * 8);
#define PG8_SA(b, h) (((b) * 2 + (h)) * HTB)
#define PG8_SB(b, h) ((4 + (b) * 2 + (h)) * HTB)
#define PG8_STAGE(bufoff, gbase, voff) do { _Pragma("unroll") for (int _i = 0; _i < 2; ++_i) \
        __builtin_amdgcn_global_load_lds((const unsigned*)((const char*)(gbase) + (voff)[_i]), (LAS unsigned*)(lds + (bufoff) + ldsw + _i * 8192), 16, 0, 0); } while (0)
#define PG8_STAGE_A1(bufoff, gbase, va) do { if constexpr (Epi::F8) PG8_STAGE(bufoff, (gbase) + hstep, (va)[0]); else PG8_STAGE(bufoff, gbase, (va)[1]); } while (0)
#define PG8_LDA(dst, b, h) do { if constexpr (Epi::F8) { _Pragma("unroll") for (int m = 0; m < 4; ++m) dst##8[m] = PG8_CAT8(*(const LAS bf16x8*)(lds + PG8_SA(b, h) + aoff + m * 2048), *(const LAS bf16x8*)(lds + PG8_SA(b, h) + aoff + m * 2048 + 1024)); } \
        else { _Pragma("unroll") for (int m = 0; m < 4; ++m) _Pragma("unroll") for (int k = 0; k < 2; ++k) dst[m][k] = *(const LAS bf16x8*)(lds + PG8_SA(b, h) + aoff + m * 2048 + k * 1024); } } while (0)
#define PG8_LDB(dst, b, h) do { if constexpr (Epi::F8) { _Pragma("unroll") for (int n = 0; n < 2; ++n) dst##8[n] = PG8_CAT8(*(const LAS bf16x8*)(lds + PG8_SB(b, h) + boff + n * 2048), *(const LAS bf16x8*)(lds + PG8_SB(b, h) + boff + n * 2048 + 1024)); } \
        else { _Pragma("unroll") for (int n = 0; n < 2; ++n) _Pragma("unroll") for (int k = 0; k < 2; ++k) dst[n][k] = *(const LAS bf16x8*)(lds + PG8_SB(b, h) + boff + n * 2048 + k * 1024); } } while (0)
#define PG8_MMA(ai, bj, At, Bt) do { __builtin_amdgcn_s_setprio(1); _Pragma("unroll") for (int m = 0; m < 4; ++m) _Pragma("unroll") for (int n = 0; n < 2; ++n) _Pragma("unroll") for (int k = 0; k < 2; ++k) \
        { if constexpr (Epi::F8) { if (k == 0) asm volatile("v_mfma_f32_16x16x128_f8f6f4 %0, %1, %2, %0" : "+v"(acc[ai][bj][m][n]) : "v"(Bt##8[n]), "v"(At##8[m])); }   \
          else if constexpr (Epi::I8) acc[ai][bj][m][n] = __builtin_amdgcn_mfma_i32_16x16x64_i8(__builtin_bit_cast(i32x4, Bt[n][k]), __builtin_bit_cast(i32x4, At[m][k]), acc[ai][bj][m][n], 0, 0, 0); \
          else acc[ai][bj][m][n] = __builtin_amdgcn_mfma_f32_16x16x32_bf16(Bt[n][k], At[m][k], acc[ai][bj][m][n], 0, 0, 0); } __builtin_amdgcn_s_setprio(0); } while (0)
#define PG8_CAT8(lo, hi) __builtin_shufflevector(__builtin_bit_cast(i32x4, lo), __builtin_bit_cast(i32x4, hi), 0, 1, 2, 3, 4, 5, 6, 7)
#define PG8_WAIT_V(n) asm volatile("s_waitcnt vmcnt(" #n ")" ::: "memory")
#define PG8_WAIT_L(n) asm volatile("s_waitcnt lgkmcnt(" #n ")" ::: "memory")
#define PG8_BAR __builtin_amdgcn_s_barrier()
#define PG8_SCHED __builtin_amdgcn_sched_barrier(0)
#define PG8_SETVA(va, u) do { int _t = tid; asm volatile("" : "+v"(_t));     \
        _Pragma("unroll") for (int _i = 0; _i < 2; ++_i) { int _R, _C; stage_rc(_t * 16 + _i * 8192, _R, _C); _Pragma("unroll") for (int _h = 0; _h < 2; ++_h) va[_h][_i] = S.arow_off(u, _h * HALF + _R) + (unsigned)_C * 2u; } } while (0)
    Unit cur, nxt; int ui = 0;
    if (!S.next(0, cur)) return;
    typedef typename AccT<Epi::I8>::type acc_t;
    acc_t acc[2][2][4][2];
#pragma unroll
    for (int a = 0; a < 2; ++a)
#pragma unroll
        for (int b = 0; b < 2; ++b)
#pragma unroll
            for (int m = 0; m < 4; ++m)
#pragma unroll
                for (int n = 0; n < 2; ++n) acc[a][b][m][n] = (acc_t){0, 0, 0, 0};
    bf16x8 At[4][2], B0[2][2], B1[2][2]; i32x8 At8[4], B08[2], B18[2];
    unsigned vaC[2][2], vaN[2][2];
    PG8_SETVA(vaC, cur);
    const char* cA = S.a_tile(cur); const char* cB = S.b_tile(cur);
    PG8_STAGE(PG8_SB(0, 0), cB, voffB); PG8_STAGE(PG8_SB(0, 1), cB + hstep, voffB); PG8_STAGE(PG8_SA(0, 0), cA, vaC[0]); PG8_STAGE_A1(PG8_SA(0, 1), cA, vaC);
    if (wr == 1) PG8_BAR;
    PG8_WAIT_V(2); PG8_BAR;
    PG8_STAGE(PG8_SB(1, 0), cB + kstep, voffB); PG8_STAGE(PG8_SA(1, 0), cA + kstep, vaC[0]); PG8_STAGE(PG8_SB(1, 1), cB + hstep + kstep, voffB);
    PG8_WAIT_V(6); PG8_BAR;
    for (;;) {
        const bool has_next = S.next(ui + 1, nxt);
        const char* nA = has_next ? S.a_tile(nxt) : cA; const char* nB = has_next ? S.b_tile(nxt) : cB;
        if (has_next && !Epi::F8) { PG8_SETVA(vaN, nxt); } else {
#pragma unroll
            for (int h = 0; h < 2; ++h)
#pragma unroll
                for (int i = 0; i < 2; ++i) vaN[h][i] = vaC[h][i]; }
        for (int t = 0; t < nt; t += 2) {
            const bool last = (t == nt - 2);
            const char* a1 = cA + (size_t)(t + 1) * kstep;
            const char* a2 = last ? nA : cA + (size_t)(t + 2) * kstep; const char* b2 = last ? nB : cB + (size_t)(t + 2) * kstep;
            if constexpr (Epi::F8) asm volatile("" : "+s"(a1), "+s"(a2), "+s"(b2));
            const char* a3 = a2 + kstep; const char* b3 = b2 + kstep;
            unsigned v2[2][2];
#pragma unroll
            for (int h = 0; h < 2; ++h)
#pragma unroll
                for (int i = 0; i < 2; ++i) v2[h][i] = last ? vaN[h][i] : vaC[h][i];
            PG8_LDB(B0, 0, 0); PG8_LDB(B1, 0, 1); PG8_SCHED; PG8_LDA(At, 0, 0); PG8_STAGE_A1(PG8_SA(1, 1), a1, vaC);
            PG8_WAIT_V(8); PG8_WAIT_L(0); PG8_BAR; PG8_MMA(0, 0, At, B0); PG8_MMA(0, 1, At, B1); PG8_BAR; PG8_SCHED;
            PG8_LDA(At, 0, 1); PG8_STAGE(PG8_SB(0, 0), b2, voffB); PG8_STAGE(PG8_SB(0, 1), b2 + hstep, voffB); PG8_STAGE(PG8_SA(0, 0), a2, v2[0]);
            PG8_WAIT_V(8); PG8_WAIT_L(0); PG8_BAR; PG8_MMA(1, 0, At, B0); PG8_MMA(1, 1, At, B1); PG8_BAR; PG8_SCHED;
            PG8_LDB(B0, 1, 0); PG8_LDB(B1, 1, 1); PG8_SCHED; PG8_LDA(At, 1, 0); PG8_STAGE_A1(PG8_SA(0, 1), a2, v2);
            PG8_WAIT_V(8); PG8_WAIT_L(0); PG8_BAR; PG8_MMA(0, 0, At, B0); PG8_MMA(0, 1, At, B1); PG8_BAR; PG8_SCHED;
            PG8_LDA(At, 1, 1); PG8_STAGE(PG8_SB(1, 0), b3, voffB); PG8_STAGE(PG8_SB(1, 1), b3 + hstep, voffB); PG8_STAGE(PG8_SA(1, 0), a3, v2[0]);
            PG8_WAIT_V(8); PG8_WAIT_L(0); PG8_BAR; PG8_MMA(1, 0, At, B0); PG8_MMA(1, 1, At, B1); PG8_BAR; PG8_SCHED;
        }
        if constexpr (Epi::F8) { asm volatile("s_nop 15\n\ts_nop 15" ::: "memory");
#pragma unroll
            for (int a = 0; a < 2; ++a)
#pragma unroll
                for (int b = 0; b < 2; ++b)
#pragma unroll
                    for (int m = 0; m < 4; ++m) asm volatile("" : "+v"(acc[a][b][m][0]), "+v"(acc[a][b][m][1])); }
        if constexpr (ALIGN_EPI) { if (wr == 0) PG8_BAR; }
        E(acc, cur, wr, wc, fr, fq);
        if (!has_next) break;
#pragma unroll
        for (int a = 0; a < 2; ++a)
#pragma unroll
            for (int b = 0; b < 2; ++b)
#pragma unroll
                for (int m = 0; m < 4; ++m)
#pragma unroll
                    for (int n = 0; n < 2; ++n) acc[a][b][m][n] = (acc_t){0, 0, 0, 0};
        cur = nxt; cA = nA; cB = nB; ++ui;
#pragma unroll
        for (int h = 0; h < 2; ++h)
#pragma unroll
            for (int i = 0; i < 2; ++i) vaC[h][i] = vaN[h][i];
        if constexpr (ALIGN_EPI) { if (wr == 1) PG8_BAR; }
    }
    PG8_WAIT_V(0);
    if constexpr (!ALIGN_EPI) { if (wr == 0) PG8_BAR; }
    PG8_BAR;
#undef PG8_SA
#undef PG8_SB
#undef PG8_STAGE
#undef PG8_STAGE_A1
#undef PG8_LDA
#undef PG8_LDB
#undef PG8_MMA
#undef PG8_WAIT_V
#undef PG8_CAT8
#undef PG8_WAIT_L
#undef PG8_BAR
#undef PG8_SCHED
#undef PG8_SETVA
}
}

#define XB_TMO      128
#define XB_XCNT(j)  (256  + 64 * (j))
#define XB_XSUB(j)  (1280 + 64 * (j))
#define XB_XGEN(j)  (2304 + 64 * (j))
#define XB_TOP      3328
#define XB_TOPGEN   3392
#define XCD_BAR_WORDS 3456
#define XB_SPIN_CAP (1u << 22)
__device__ __forceinline__ unsigned xb_ld(unsigned* p)              { return __hip_atomic_load(p, __ATOMIC_RELAXED, __HIP_MEMORY_SCOPE_AGENT); }
__device__ __forceinline__ unsigned xb_add(unsigned* p, unsigned v) { return __hip_atomic_fetch_add(p, v, __ATOMIC_RELAXED, __HIP_MEMORY_SCOPE_AGENT); }
__device__ __forceinline__ unsigned xb_xcc_id() { return (unsigned)__builtin_amdgcn_s_getreg((3 << 11) | 20) & 0xFu; }
#define XB_SPIN(cond, bar) do { unsigned _sp = 0; while (cond) { __builtin_amdgcn_s_sleep(1); \
    if ((++_sp & 255u) == 0u) { if (xb_ld(&(bar)[XB_TMO])) break; if (_sp > XB_SPIN_CAP) { atomicAdd(&(bar)[XB_TMO], 1u); break; } } } } while (0)
struct XcdBarrier { unsigned* bar; unsigned x; volatile LAS unsigned* st; int wv; };
__device__ __forceinline__ XcdBarrier xcd_barrier_post(unsigned* bar, volatile LAS unsigned* st) {
    XcdBarrier b; b.bar = bar; b.x = xb_xcc_id(); b.st = st;
    if (threadIdx.x == 0) (void)xb_add(&bar[XB_XCNT(b.x)], 1u);
    return b;
}
__device__ __forceinline__ void xcd_barrier_complete(unsigned* bar, unsigned x, unsigned& nloc, unsigned& nx) {
    const unsigned G = gridDim.x * gridDim.y * gridDim.z;
    unsigned sum, cnt, mine, sp = 0u;
    for (;;) {
        sum = 0u; cnt = 0u; mine = 0u;
#pragma nounroll
        for (unsigned j = 0; j < 16; ++j) { const unsigned c = xb_ld(&bar[XB_XCNT(j)]); sum += c; cnt += (c > 0u) ? 1u : 0u; mine = (j == x) ? c : mine; }
        if (sum == G) break;
        __builtin_amdgcn_s_sleep(1);
        if ((++sp & 255u) == 0u) { if (xb_ld(&bar[XB_TMO])) break; if (sp > XB_SPIN_CAP) { atomicAdd(&bar[XB_TMO], 1u); break; } }
    }
    nloc = mine > 0u ? mine : 1u; nx = cnt > 0u ? cnt : 1u;
}
__device__ __forceinline__ void xcd_barrier(const XcdBarrier& b) {
    asm volatile("s_waitcnt vmcnt(0)" ::: "memory");
    __syncthreads();
    if (b.wv == 0 && lane_now() == 0) {
        unsigned* bar = b.bar;
        __builtin_amdgcn_s_waitcnt(0);
        unsigned nloc = b.st[0], nx = b.st[1];
        if (nloc == 0u) { xcd_barrier_complete(bar, b.x, nloc, nx); b.st[0] = nloc; b.st[1] = nx; }
        const unsigned old = xb_add(&bar[XB_XSUB(b.x)], 1u);
        const unsigned gen = old / nloc;
        if (old + 1u == (gen + 1u) * nloc) {
            __builtin_amdgcn_fence(__ATOMIC_RELEASE, "agent");
            asm volatile("s_waitcnt vmcnt(0)" ::: "memory");
            const unsigned og = xb_add(&bar[XB_TOP], 1u);
            const unsigned tg = og / nx;
            if (og + 1u == (tg + 1u) * nx) xb_add(&bar[XB_TOPGEN], 1u);
            else XB_SPIN(xb_ld(&bar[XB_TOPGEN]) == tg, bar);
            __builtin_amdgcn_fence(__ATOMIC_ACQUIRE, "agent");
            xb_add(&bar[XB_XGEN(b.x)], 1u);
            asm volatile("s_waitcnt vmcnt(0)" ::: "memory");
        } else {
            XB_SPIN(xb_ld(&bar[XB_XGEN(b.x)]) == gen, bar);
            __builtin_amdgcn_fence(__ATOMIC_ACQUIRE, "agent");
            asm volatile("s_waitcnt vmcnt(0)" ::: "memory");
        }
    }
    __syncthreads();
}

namespace attn_body {
typedef unsigned short bf16;
using bf16x8=__attribute__((ext_vector_type(8)))short;
using s16x4=__attribute__((ext_vector_type(4)))short;
using f32x16=__attribute__((ext_vector_type(16)))float;
using u32x4=__attribute__((ext_vector_type(4)))unsigned;
constexpr int D=64,DM=NIN,OPITCH=1024;
constexpr int NW=8,QBLK=32,QB=QBLK*NW,KVBLK=64;
__device__ __forceinline__ int crow(int r,int hi){return (r&3)+8*(r>>2)+4*hi;}
#define SBAR() __builtin_amdgcn_sched_barrier(0)
constexpr int NSLOT=3, SLOTB=8192;
constexpr int LDS_K=0, LDS_V=NSLOT*SLOTB, LDS_WS=2*NSLOT*SLOTB, LDS_OST=LDS_WS+NW*64*4, LDS_BYTES=LDS_OST+NW*8192;
__device__ __forceinline__ void glds16(const void*gsrc,unsigned lds_dst){unsigned keep;
  asm volatile("s_mov_b32 %0, m0\n\ts_mov_b32 m0, %2\n\ts_nop 0\n\tglobal_load_lds_dwordx4 %1, off\n\ts_mov_b32 m0, %0":"=&s"(keep):"v"(gsrc),"s"(lds_dst):"memory");}
__device__ __forceinline__ float max3f(float a,float b,float c){float r;asm("v_max3_f32 %0, %1, %2, %3":"=v"(r):"v"(a),"v"(b),"v"(c));return r;}
__device__ __forceinline__ float max2f(float a,float b){float r;asm("v_max_f32_e32 %0, %1, %2":"=v"(r):"v"(a),"v"(b));return r;}
__device__ __forceinline__ float fadd_s(float a,float b){float r;asm("v_add_f32_e32 %0, %1, %2":"=v"(r):"v"(a),"v"(b));return r;}
__device__ __forceinline__ float fsub_s(float a,float b){float r;asm("v_sub_f32_e32 %0, %1, %2":"=v"(r):"v"(a),"v"(b));return r;}
typedef float f32x2_t __attribute__((ext_vector_type(2))); typedef __bf16 bf16x2_t __attribute__((ext_vector_type(2)));
__device__ __forceinline__ unsigned cvtpk_s(float lo,float hi){f32x2_t v={lo,hi};bf16x2_t b=__builtin_convertvector(v,bf16x2_t);return __builtin_bit_cast(unsigned,b);}
#define WAIT_BAR(N) asm volatile("s_waitcnt vmcnt(" #N ") lgkmcnt(0)\n\ts_barrier":::"memory")

__device__ __forceinline__ void qkt(f32x16&p0,f32x16&p1,const char*Kslot,const bf16x8*qr,const f32x16&negm,int r32,int hi){
  const char*kb=Kslot+hi*1024+r32*16;
  #pragma unroll
  for(int d0=0;d0<4;++d0){
    const bf16x8 b0=*reinterpret_cast<const bf16x8*>(kb+d0*2048);
    const bf16x8 b1=*reinterpret_cast<const bf16x8*>(kb+d0*2048+512);
    if(d0==0){p0=__builtin_amdgcn_mfma_f32_32x32x16_bf16(b0,qr[0],negm,0,0,0);p1=__builtin_amdgcn_mfma_f32_32x32x16_bf16(b1,qr[0],negm,0,0,0);}
    else{p0=__builtin_amdgcn_mfma_f32_32x32x16_bf16(b0,qr[d0],p0,0,0,0);p1=__builtin_amdgcn_mfma_f32_32x32x16_bf16(b1,qr[d0],p1,0,0,0);}}
}
typedef __attribute__((address_space(3))) const char* lds_cptr;
typedef short v4i16_t __attribute__((ext_vector_type(4)));
__device__ __forceinline__ void kload8(bf16x8*kf,lds_cptr kp){
  kf[0]=*(const __attribute__((address_space(3))) bf16x8*)(kp);      kf[1]=*(const __attribute__((address_space(3))) bf16x8*)(kp+512);
  kf[2]=*(const __attribute__((address_space(3))) bf16x8*)(kp+2048); kf[3]=*(const __attribute__((address_space(3))) bf16x8*)(kp+2560);
  kf[4]=*(const __attribute__((address_space(3))) bf16x8*)(kp+4096); kf[5]=*(const __attribute__((address_space(3))) bf16x8*)(kp+4608);
  kf[6]=*(const __attribute__((address_space(3))) bf16x8*)(kp+6144); kf[7]=*(const __attribute__((address_space(3))) bf16x8*)(kp+6656);
}
__device__ __forceinline__ void kload2(bf16x8*kf,lds_cptr kp,int j){ kf[2*j]=*(const __attribute__((address_space(3))) bf16x8*)(kp+j*2048); kf[2*j+1]=*(const __attribute__((address_space(3))) bf16x8*)(kp+j*2048+512); }
__device__ __forceinline__ s16x4 vtr(lds_cptr p){ return __builtin_bit_cast(s16x4,__builtin_amdgcn_ds_read_tr16_b64_v4i16((__attribute__((address_space(3))) v4i16_t*)p)); }
__device__ __forceinline__ float rowmax(const f32x16&p0,const f32x16&p1){
  float a=max3f(p0[0],p0[1],p1[0]),b=max3f(p0[2],p0[3],p1[1]);a=max3f(a,p1[2],p1[3]);
  #pragma unroll
  for(int r=4;r<16;r+=4){a=max3f(a,p0[r],p0[r+1]);b=max3f(b,p0[r+2],p0[r+3]);a=max3f(a,p1[r],p1[r+1]);b=max3f(b,p1[r+2],p1[r+3]);}
  const float m=max2f(a,b);
  auto rr=__builtin_amdgcn_permlane32_swap(__float_as_uint(m),__float_as_uint(m),false,false);
  return max2f(__uint_as_float(rr[0]),__uint_as_float(rr[1]));
}
__device__ __forceinline__ void pv(f32x16*o,int vb,bf16x8 pa0,bf16x8 pa1,bf16x8 pa2,bf16x8 pa3){
  #pragma unroll
  for(int d0=0;d0<2;++d0){s16x4 lo[4],hi[4];
    #pragma unroll
    for(int ks=0;ks<4;++ks){
      asm volatile("ds_read_b64_tr_b16 %0,%1 offset:%c2":"=&v"(lo[ks]):"v"(vb),"i"(d0*4096+ks*1024):"memory");
      asm volatile("ds_read_b64_tr_b16 %0,%1 offset:%c2":"=&v"(hi[ks]):"v"(vb),"i"(d0*4096+ks*1024+512):"memory");}
    asm volatile("s_waitcnt lgkmcnt(0)":::"memory");SBAR();
    #define PK(k) (bf16x8){lo[k][0],lo[k][1],lo[k][2],lo[k][3],hi[k][0],hi[k][1],hi[k][2],hi[k][3]}
    o[d0]=__builtin_amdgcn_mfma_f32_32x32x16_bf16(pa0,PK(0),o[d0],0,0,0);
    o[d0]=__builtin_amdgcn_mfma_f32_32x32x16_bf16(pa1,PK(1),o[d0],0,0,0);
    o[d0]=__builtin_amdgcn_mfma_f32_32x32x16_bf16(pa2,PK(2),o[d0],0,0,0);
    o[d0]=__builtin_amdgcn_mfma_f32_32x32x16_bf16(pa3,PK(3),o[d0],0,0,0);
    #undef PK
  }
}

template<int THRL,int EPI> __device__ __forceinline__ void attn_unit(const bf16*Q0,const bf16*__restrict__ Kb,const bf16*__restrict__ Vb,long dC,int ntL,int NT,unsigned char*Y0,float lam,float oml,const float*subln,char*shm,int wv){
  const int tid_=wv*64+lane_now();
  const int tid=tid_,lane=tid&63,r32=lane&31,hi=lane>>5; const int wid=__builtin_amdgcn_readfirstlane(tid>>6);
  const bf16*Qw=Q0+(long)(wid*QBLK)*DM;
  const bf16*Kh=Kb,*Vh=Vb;
  const unsigned lds0=(unsigned)(uintptr_t)shm;
  float*wsf=(float*)(shm+LDS_WS)+wid*64;
  const bf16*ksrc=Kh+(long)lane*DM+wid*8;
  const bf16*vsrc=Vh+(long)(16*(wid&3)+(lane>>2))*DM+(wid>>2)*32+(lane&3)*8;
  const unsigned kdst=lds0+LDS_K+wid*1024, vdst=lds0+LDS_V+wid*1024;
  #define TOFF(t) ((long)(t)*KVBLK*DM+(((t)<ntL)?0l:dC))
  #define DMA_K(t,slot) glds16(ksrc+TOFF(t),(unsigned)__builtin_amdgcn_readfirstlane(kdst+(slot)))
  #define DMA_V(t,slot) glds16(vsrc+TOFF(t),(unsigned)__builtin_amdgcn_readfirstlane(vdst+(slot)))
  const int vb0=(int)(lds0+LDS_V)+((lane>>4)&1)*32+(lane&3)*8+(4*hi+((lane&15)>>2))*64;
  const char*Kbase=shm+LDS_K; bf16x8 kf[8];
  const lds_cptr shm3=(lds_cptr)shm; const lds_cptr kp0=shm3+LDS_K+hi*1024+r32*16; const lds_cptr vp0=shm3+LDS_V+((lane>>4)&1)*32+(lane&3)*8+(4*hi+((lane&15)>>2))*64;
  DMA_K(0,0);DMA_V(0,0);DMA_K(1,SLOTB);
  bf16x8 qr[4];
  if(EPI==0){
    #pragma unroll
    for(int d0=0;d0<4;++d0)qr[d0]=*reinterpret_cast<const bf16x8*>(&Qw[(long)r32*DM+d0*16+hi*8]);
  }else{ const bf16x8 z={0,0,0,0,0,0,0,0}; const bf16x8 f0=*reinterpret_cast<const bf16x8*>(&Qw[(long)r32*DM+hi*8]),f1=*reinterpret_cast<const bf16x8*>(&Qw[(long)r32*DM+16+hi*8]);
    qr[0]=EPI==1?f0:z; qr[1]=EPI==1?f1:z; qr[2]=EPI==2?f0:z; qr[3]=EPI==2?f1:z; }
  float mhat=0.f,l_reg=0.f;f32x16 o[2];o[0]=f32x16{};o[1]=f32x16{};f32x16 negm=f32x16{};asm volatile("":"+v"(negm));
  #define CMASK(P0,P1,t) do{}while(0)
  bool resc=false;
  #define START(P0,P1) do{ const float rm=rowmax(P0,P1); resc=false; \
    { const float dl=rm; mhat=fadd_s(mhat,dl); \
      _Pragma("unroll") for(int r=0;r<16;++r){P0[r]=fsub_s(P0[r],dl);P1[r]=fsub_s(P1[r],dl);} \
      _Pragma("unroll") for(int r=0;r<16;++r)negm[r]=-mhat; asm volatile("":"+v"(negm)); } \
    _Pragma("unroll") for(int r=0;r<16;++r)P0[r]=__builtin_amdgcn_exp2f(P0[r]); }while(0)
  #define RESC() do{ if(resc){ asm volatile("s_waitcnt lgkmcnt(0)":::"memory"); \
      _Pragma("unroll") for(int d_=0;d_<2;++d_) _Pragma("unroll") for(int r=0;r<16;++r)o[d_][r]*=wsf[crow(r,hi)]; } }while(0)
  f32x16 pA0,pA1,pB0,pB1;
  int sl_prev=0,sl_cur=0,sl_next=SLOTB;
  #define ROT() do{sl_prev=sl_cur;sl_cur=sl_next;sl_next=(sl_next==(NSLOT-1)*SLOTB)?0:sl_next+SLOTB;}while(0)
  DMA_K(2,2*SLOTB);
  WAIT_BAR(3);
  qkt(pA0,pA1,Kbase,qr,negm,r32,hi);asm volatile("s_nop 15\n\ts_nop 7":"+v"(pA0),"+v"(pA1));CMASK(pA0,pA1,0);
  START(pA0,pA1);
  _Pragma("unroll") for(int r=0;r<16;++r)pA1[r]=__builtin_amdgcn_exp2f(pA1[r]);
  WAIT_BAR(0);
  DMA_K(3,0);DMA_V(1,SLOTB);
  ROT();
  kload8(kf,kp0+sl_cur);
  WAIT_BAR(2);
  s16x4 vlo[8],vhi[8]; u32x4 pw0,pw1,pw2,pw3;
  #define PKW(P,B) cvtpk_s(P[B],P[B+1])
  #define PAF(k) __builtin_bit_cast(bf16x8,pw##k)
  #define VFR(i) (bf16x8){vlo[i][0],vlo[i][1],vlo[i][2],vlo[i][3],vhi[i][0],vhi[i][1],vhi[i][2],vhi[i][3]}
  #define PIN(x) asm volatile("":"+v"(x))
  #define MX3(a,b,c) __builtin_fmaxf(__builtin_fmaxf((a),(b)),(c))
  #define GAPA(MF,A0,A1,A2,A3,W0,W1,PW) do{ MF; sacc+=A0; sacc+=A1; sacc+=A2; sacc+=A3; PIN(sacc); W0; W1; PIN(PW); SBAR(); }while(0)
  #define EX(v) __builtin_amdgcn_exp2f(v)
  #define GAPB(MF,X,B) do{ MF; X[B]=EX(X[B]); X[B+1]=EX(X[B+1]); X[B+2]=EX(X[B+2]); X[B+3]=EX(X[B+3]); PIN(X); SBAR(); }while(0)
  #define VRD(i) do{ vlo[i]=vtr(vp_+(((i)>>2)*4096+((i)&3)*1024)); vhi[i]=vtr(vp_+(((i)>>2)*4096+((i)&3)*1024+512)); }while(0)
  #define KRD(G,j) do{ if((G)&&(EPI==0||(EPI==1&&(j)<2)||(EPI==2&&(j)>=2))){ kload2(kf,kp0+sl_next,j); SBAR(); } }while(0)
  #define STEP(C0,C1,P0,P1,t,GK,GV,GL) do{ SBAR(); \
    const lds_cptr vp_=vp0+sl_prev; \
    VRD(0); SBAR(); float sacc=(P0[0]+P0[1]); \
    GAPA(if(EPI!=2)C0=__builtin_amdgcn_mfma_f32_32x32x16_bf16(kf[0],qr[0],negm,0,0,0), P0[2],P0[3],P0[4],P0[5],     pw0[0]=PKW(P0,0), pw0[1]=PKW(P0,2), pw0); \
    VRD(4); SBAR(); GAPA(if(EPI!=2)C1=__builtin_amdgcn_mfma_f32_32x32x16_bf16(kf[1],qr[0],negm,0,0,0), P0[6],P0[7],P0[8],P0[9],     pw0[2]=PKW(P0,4), pw0[3]=PKW(P0,6), pw0); \
    VRD(1); SBAR(); GAPA(if(EPI!=2)C0=__builtin_amdgcn_mfma_f32_32x32x16_bf16(kf[2],qr[1],C0,0,0,0),   P0[10],P0[11],P0[12],P0[13], pw1[0]=PKW(P0,8), pw1[1]=PKW(P0,10), pw1); \
    VRD(5); SBAR(); GAPA(if(EPI!=2)C1=__builtin_amdgcn_mfma_f32_32x32x16_bf16(kf[3],qr[1],C1,0,0,0),   P0[14],P0[15],P1[0],P1[1],   pw1[2]=PKW(P0,12),pw1[3]=PKW(P0,14), pw1); \
    VRD(2); SBAR(); GAPA(if(EPI!=1)C0=__builtin_amdgcn_mfma_f32_32x32x16_bf16(kf[4],qr[2],EPI==2?negm:C0,0,0,0),   P1[2],P1[3],P1[4],P1[5],     pw2[0]=PKW(P1,0), pw2[1]=PKW(P1,2), pw2); \
    VRD(6); SBAR(); GAPA(if(EPI!=1)C1=__builtin_amdgcn_mfma_f32_32x32x16_bf16(kf[5],qr[2],EPI==2?negm:C1,0,0,0),   P1[6],P1[7],P1[8],P1[9],     pw2[2]=PKW(P1,4), pw2[3]=PKW(P1,6), pw2); \
    VRD(3); SBAR(); GAPA(if(EPI!=1)C0=__builtin_amdgcn_mfma_f32_32x32x16_bf16(kf[6],qr[3],C0,0,0,0),   P1[10],P1[11],P1[12],P1[13], pw3[0]=PKW(P1,8), pw3[1]=PKW(P1,10), pw3); \
    VRD(7); SBAR(); GAPA(if(EPI!=1)C1=__builtin_amdgcn_mfma_f32_32x32x16_bf16(kf[7],qr[3],C1,0,0,0),   P1[14],P1[15],0.f,0.f,       pw3[2]=PKW(P1,12),pw3[3]=PKW(P1,14), pw3); \
    l_reg+=sacc; \
    if(GK){DMA_K((t)+3,sl_cur);} if(GV){DMA_V((t)+1,sl_next);} \
    CMASK(C0,C1,t); \
    { float a=MX3(C0[0],C0[1],C1[0]),b=MX3(C0[2],C0[3],C1[1]); a=MX3(a,C1[2],C1[3]); \
      _Pragma("unroll") for(int r=4;r<16;r+=4){a=MX3(a,C0[r],C0[r+1]);b=MX3(b,C0[r+2],C0[r+3]);a=MX3(a,C1[r],C1[r+1]);b=MX3(b,C1[r+2],C1[r+3]);} \
      float rm=__builtin_fmaxf(a,b); { auto rr=__builtin_amdgcn_permlane32_swap(__float_as_uint(rm),__float_as_uint(rm),false,false); rm=__builtin_fmaxf(__uint_as_float(rr[0]),__uint_as_float(rr[1])); } \
      resc=false; \
      if(__builtin_expect(__any(rm>(float)THRL),0)){ const float dl=__builtin_fmaxf(rm,0.f); mhat+=dl; \
        _Pragma("unroll") for(int r=0;r<16;++r){C0[r]-=dl;C1[r]-=dl;} \
        _Pragma("unroll") for(int r=0;r<16;++r)negm[r]=-mhat; asm volatile("":"+v"(negm)); \
        const float f=__builtin_amdgcn_exp2f(-dl); l_reg*=f; if(hi==0)wsf[r32]=f; resc=true; } } \
    SBAR(); \
    GAPB(o[0]=__builtin_amdgcn_mfma_f32_32x32x16_bf16(PAF(0),VFR(0),o[0],0,0,0), C0,0); \
    GAPB(o[1]=__builtin_amdgcn_mfma_f32_32x32x16_bf16(PAF(0),VFR(4),o[1],0,0,0), C0,4); \
    KRD(GL,0); GAPB(o[0]=__builtin_amdgcn_mfma_f32_32x32x16_bf16(PAF(1),VFR(1),o[0],0,0,0), C0,8); \
    KRD(GL,1); GAPB(o[1]=__builtin_amdgcn_mfma_f32_32x32x16_bf16(PAF(1),VFR(5),o[1],0,0,0), C0,12); \
    KRD(GL,2); GAPB(o[0]=__builtin_amdgcn_mfma_f32_32x32x16_bf16(PAF(2),VFR(2),o[0],0,0,0), C1,0); \
    KRD(GL,3); GAPB(o[1]=__builtin_amdgcn_mfma_f32_32x32x16_bf16(PAF(2),VFR(6),o[1],0,0,0), C1,4); \
    GAPB(o[0]=__builtin_amdgcn_mfma_f32_32x32x16_bf16(PAF(3),VFR(3),o[0],0,0,0), C1,8); \
    GAPB(o[1]=__builtin_amdgcn_mfma_f32_32x32x16_bf16(PAF(3),VFR(7),o[1],0,0,0), C1,12); \
    }while(0)
  int t=1;
  for(;t+5<NT;t+=2){
    STEP(pB0,pB1,pA0,pA1,t,true,true,true);     WAIT_BAR(2); RESC(); ROT();
    STEP(pA0,pA1,pB0,pB1,t+1,true,true,true);   WAIT_BAR(2); RESC(); ROT();
  }
  #define ENDW(tt) do{ if((tt)+3<NT){WAIT_BAR(2);} else if((tt)+2<NT){WAIT_BAR(1);} else {WAIT_BAR(0);} }while(0)
  for(;t+1<NT;t+=2){
    STEP(pB0,pB1,pA0,pA1,t,(t+3<NT),(t+1<NT),(t+1<NT));       ENDW(t);   RESC(); ROT();
    STEP(pA0,pA1,pB0,pB1,t+1,(t+4<NT),(t+2<NT),(t+2<NT));     ENDW(t+1); RESC(); ROT();
  }
  STEP(pB0,pB1,pA0,pA1,NT-1,false,false,false); RESC();
  { float sacc=pB0[0]+pB0[1]; _Pragma("unroll") for(int r=2;r<16;++r)sacc+=pB0[r]; _Pragma("unroll") for(int r=0;r<16;++r)sacc+=pB1[r]; l_reg+=sacc;
    pw0=(u32x4){PKW(pB0,0),PKW(pB0,2),PKW(pB0,4),PKW(pB0,6)};pw1=(u32x4){PKW(pB0,8),PKW(pB0,10),PKW(pB0,12),PKW(pB0,14)};pw2=(u32x4){PKW(pB1,0),PKW(pB1,2),PKW(pB1,4),PKW(pB1,6)};pw3=(u32x4){PKW(pB1,8),PKW(pB1,10),PKW(pB1,12),PKW(pB1,14)};
    SBAR(); pv(o,vb0+sl_cur,PAF(0),PAF(1),PAF(2),PAF(3)); }
  #undef PKW
  #undef PAF
  #undef VFR
  #undef PIN
  #undef MX3
  #undef GAPA
  #undef GAPB
  #undef EX
  #undef VRD
  #undef KRD
  #undef STEP
  #undef ENDW
  l_reg=sum32(l_reg);
  if(hi==0)wsf[32+r32]=l_reg;asm volatile("s_waitcnt lgkmcnt(0)":::"memory");
  float rli[16];
  #pragma unroll
  for(int r=0;r<16;++r)rli[r]=__builtin_amdgcn_rcpf(wsf[32+crow(r,hi)]);
  { float*stg=(float*)(shm+LDS_OST)+wid*2048;
    #pragma unroll
    for(int r=0;r<16;++r){const int orow=crow(r,hi);
      #pragma unroll
      for(int d0=0;d0<2;++d0){ const int ix=orow*64+d0*32+r32; const float v=o[d0][r]*rli[r]; if(EPI==2)stg[ix]=stg[ix]-lam*v; else stg[ix]=v; } }
    asm volatile("s_waitcnt lgkmcnt(0)":::"memory");
    if(EPI!=1){ unsigned char*Yw=Y0+(long)(wid*QBLK)*OPITCH;
      #pragma unroll
      for(int i=0;i<4;++i){const int row=i*8+(lane>>3),ch=lane&7; const f32x4 a=*(const f32x4*)(stg+row*64+ch*8),b=*(const f32x4*)(stg+row*64+ch*8+4);
        float v[8]={a[0],a[1],a[2],a[3],b[0],b[1],b[2],b[3]};
        if(EPI==2){ float ss=0.f;
          #pragma unroll
          for(int j=0;j<8;++j)ss+=v[j]*v[j];
          ss+=shx<1>(ss);ss+=shx<2>(ss);ss+=shx<4>(ss);
          const float rs=rsqrtf(ss*(1.0f/64.0f)+EPS)*oml;
          #pragma unroll
          for(int j=0;j<8;++j)v[j]=v[j]*rs*subln[ch*8+j]; }
        *(u32x2*)(Yw+(long)row*OPITCH+ch*8)=pack8_fp8(v,SY8);} } }
  asm volatile("s_waitcnt lgkmcnt(0)\n\ts_barrier":::"memory");
  #undef DMA_K
  #undef DMA_V
  #undef TOFF
  #undef CMASK
  #undef START
  #undef RESC
  #undef ROT
}
constexpr int ATTN_LDS_BYTES=LDS_BYTES;
#undef SBAR
#undef WAIT_BAR
}

constexpr int RING_BYTES = 131072, LDSCTL_OFF = RING_BYTES, MISC_OFF = LDSCTL_OFF + 320, LDS_BYTES = 147456;

__device__ __forceinline__ void conv_load_z(const bf16* pr, int ch, bool ok, float (&z)[8]) {
    const u32x4 zz = {0, 0, 0, 0}; const u32x4 u = ok ? *(const u32x4*)(pr + 768 + ch) : zz, c = ok ? *(const u32x4*)(pr + 1280 + ch) : zz; float a[8], b[8]; unpack8(u, a); unpack8(c, b);
#pragma unroll
    for (int k = 0; k < 8; ++k) z[k] = a[k] * b[k];
}
template <int HN> __device__ __forceinline__ void conv_rows_t(const bf16* P, unsigned char* Y, const float* convw, int r0, int lane) {
    const int ch = (lane & 31) * 8, rb = r0 + (lane >> 5) * HN;
    float w[3][8];
#pragma unroll
    for (int j = 0; j < 3; ++j) { const f32x4 a = *(const f32x4*)(convw + j * 256 + ch), b = *(const f32x4*)(convw + j * 256 + ch + 4); w[j][0] = a[0]; w[j][1] = a[1]; w[j][2] = a[2]; w[j][3] = a[3]; w[j][4] = b[0]; w[j][5] = b[1]; w[j][6] = b[2]; w[j][7] = b[3]; }
    u32x4 zu[HN + 2], zc[HN + 2], bbw[HN]; const u32x4 zz = {0, 0, 0, 0};
#pragma unroll
    for (int i = 0; i < HN + 2; ++i) { const int row = rb + i - 1; const bool ok = row >= 0 && row < MT; const bf16* pr = P + (size_t)(ok ? row : 0) * NIN;
        zu[i] = ok ? *(const u32x4*)(pr + 768 + ch) : zz; zc[i] = ok ? *(const u32x4*)(pr + 1280 + ch) : zz; }
#pragma unroll
    for (int i = 0; i < HN; ++i) bbw[i] = *(const u32x4*)(P + (size_t)(rb + i) * NIN + 1024 + ch);
    float zm[8], z0[8], zp[8];
    { float a[8], b[8]; unpack8(zu[0], a); unpack8(zc[0], b);
#pragma unroll
      for (int k = 0; k < 8; ++k) zm[k] = a[k] * b[k];
      unpack8(zu[1], a); unpack8(zc[1], b);
#pragma unroll
      for (int k = 0; k < 8; ++k) z0[k] = a[k] * b[k]; }
#pragma unroll
    for (int i = 0; i < HN; ++i) { const int row = rb + i; const bool lat = row < ML; const int t = lat ? (row & 2047) : ((row - ML) & 255); const int slen = lat ? SEQ : CTX;
        float a[8], b[8], bb[8], o[8]; unpack8(zu[i + 2], a); unpack8(zc[i + 2], b); unpack8(bbw[i], bb); const bool hm = t > 0, hp = t + 1 < slen;
#pragma unroll
        for (int k = 0; k < 8; ++k) { zp[k] = a[k] * b[k]; o[k] = bb[k] * ((hm ? w[0][k] * zm[k] : 0.0f) + w[1][k] * z0[k] + (hp ? w[2][k] * zp[k] : 0.0f)); zm[k] = z0[k]; z0[k] = zp[k]; }
        *(u32x2*)(Y + (size_t)row * D + 512 + ch) = pack8_fp8(o, SY8); }
}
__device__ __forceinline__ void conv_rows(const bf16* P, unsigned char* Y, const float* convw, int r0, int nr, int lane) { if (nr == 18) conv_rows_t<9>(P, Y, convw, r0, lane); else conv_rows_t<8>(P, Y, convw, r0, lane); }
__device__ __forceinline__ void norm2_router_phase(const NormArgs& a, LAS unsigned char* lds, int vcu, int NGW, int tid, int lane, int wave) {
    LAS float* rwT = (LAS float*)lds;
    LAS unsigned* sel = (LAS unsigned*)(lds + 32768);
    LAS float* gat = (LAS float*)(lds + 32768 + 1024);
    LAS unsigned* lcnt = (LAS unsigned*)(lds + 32768 + 1024 + 2048);
    LAS unsigned* gbase = lcnt + 16; LAS float* rsw = (LAS float*)(gbase + 16);
    for (int i = tid; i < 8192; i += 512) rwT[(i & 7) * 1024 + (i >> 3)] = a.rw[i];
    if (tid < 16) lcnt[tid] = 0u;
    __syncthreads();
    const int rpw = a.nrows / NGW, wgrow0 = vcu * 8 * rpw;
    u32x2 vn[4]; f32x4 avn[4], svn[4];
    { const int row_ = wgrow0 + wave * rpw, b_ = row_ < ML ? row_ >> 11 : 16; const u32x2* xr = (const u32x2*)(a.XB + (size_t)row_ * D);
      const float* A_ = a.MODl + ((size_t)b_ * 6 + a.jA) * 1024; const float* S_ = a.MODl + ((size_t)b_ * 6 + a.jS) * 1024;
#pragma unroll
      for (int j = 0; j < 4; ++j) { vn[j] = xr[lane + 64 * j]; avn[j] = *(const f32x4*)(A_ + 4 * lane + 256 * j); svn[j] = *(const f32x4*)(S_ + 4 * lane + 256 * j); } }
    for (int i = 0; i < rpw; ++i) { const int rl = wave * rpw + i, row = wgrow0 + rl;
        f32x4 v[4], avc[4], svc[4]; float ss = 0.f;
#pragma unroll
        for (int j = 0; j < 4; ++j) { unpack4(vn[j], v[j]); avc[j] = avn[j]; svc[j] = svn[j]; ss += (v[j].x * v[j].x + v[j].y * v[j].y) + (v[j].z * v[j].z + v[j].w * v[j].w); }
        if (i + 1 < rpw) { const int b_ = row + 1 < ML ? (row + 1) >> 11 : 16; const u32x2* xr = (const u32x2*)(a.XB + (size_t)(row + 1) * D);
            const float* A_ = a.MODl + ((size_t)b_ * 6 + a.jA) * 1024; const float* S_ = a.MODl + ((size_t)b_ * 6 + a.jS) * 1024;
#pragma unroll
            for (int j = 0; j < 4; ++j) { vn[j] = xr[lane + 64 * j]; avn[j] = *(const f32x4*)(A_ + 4 * lane + 256 * j); svn[j] = *(const f32x4*)(S_ + 4 * lane + 256 * j); } }
        const float rstd = rsqrtf(wave_sum(ss) * (1.0f / D) + EPS);
#pragma unroll
        for (int j = 0; j < 4; ++j) v[j] = v[j] * rstd * avc[j] + svc[j];
        const float rsv = write_row_i8(v, (signed char*)a.H + (size_t)row * D, a.rs8 + row, lane);
        float lg[8];
#pragma unroll
        for (int e = 0; e < 8; ++e) { float s = 0.f;
#pragma unroll
            for (int j = 0; j < 4; ++j) { const f32x4 w4 = *(const LAS f32x4*)(rwT + e * 1024 + 4 * lane + 256 * j); s += (v[j].x * w4.x + v[j].y * w4.y) + (v[j].z * w4.z + v[j].w * w4.w); }
            lg[e] = wave_sum(s) + a.rb[e]; }
        int e0 = 0; float v0 = lg[0];
#pragma unroll
        for (int e = 1; e < 8; ++e) if (lg[e] > v0) { v0 = lg[e]; e0 = e; }
        int e1 = -1; float v1 = -3.0e38f;
#pragma unroll
        for (int e = 0; e < 8; ++e) if (e != e0 && lg[e] > v1) { v1 = lg[e]; e1 = e; }
        if (e1 < 0) e1 = (e0 + 1) & 7;
        const float g0 = 1.0f / (1.0f + expf(v1 - v0)), g1 = 1.0f - g0;
        if (lane == 0) { const unsigned s0 = __hip_atomic_fetch_add(lcnt + e0, 1u, __ATOMIC_RELAXED, __HIP_MEMORY_SCOPE_WORKGROUP), s1 = __hip_atomic_fetch_add(lcnt + 8 + e1, 1u, __ATOMIC_RELAXED, __HIP_MEMORY_SCOPE_WORKGROUP);
            sel[rl] = (unsigned)e0 | ((unsigned)e1 << 4) | (s0 << 8) | (s1 << 16); gat[2 * rl] = g0; gat[2 * rl + 1] = g1; rsw[rl] = rsv; }
    }
    __syncthreads();
    if (tid < 16) gbase[tid] = atomicAdd(a.cnt + tid, lcnt[tid]);
    __syncthreads();
    if (tid < 8 * rpw) { const unsigned sv = sel[tid]; const int e0 = sv & 15, e1 = (sv >> 4) & 15, s0 = (sv >> 8) & 255, s1 = (sv >> 16) & 255, row = wgrow0 + tid;
        const size_t i0 = (size_t)e0 * MT + gbase[e0] + s0, i1 = (size_t)(8 + e1) * MT + gbase[8 + e1] + s1;
        a.list[i0] = row; a.glist[i0] = gat[2 * tid]; a.list[i1] = row; a.glist[i1] = gat[2 * tid + 1]; a.rsl[i0] = rsw[tid]; a.rsl[i1] = rsw[tid]; }
    __syncthreads();
}

struct Args { const float* in[25]; float* out; unsigned char* ws; int ph_lo, ph_hi, li, pad; };
constexpr int PH_PER_LAYER = 12, PH_L0 = 2, PH_FINAL = PH_L0 + 4 * PH_PER_LAYER, N_PHASES = PH_FINAL + 1;
constexpr int CW_CMAX = 131072;
constexpr size_t WS_H8A = WS_P + 200 * MiB;
constexpr int CW_CMAX2 = CW_CMAX + 18 * NUP;
constexpr size_t WS_RS = WS_TAB + 256 * 1024;
enum { PH_NORM1 = 0, PH_INPROJ = 1, PH_POST = 2, PH_ATTN = 3, PH_OUTPROJ = 4, PH_NORM2 = 5, PH_UP0 = 6, PH_DN0 = 7, PH_UP1 = 8, PH_DN1 = 9 };

__global__ void __launch_bounds__(512, 2) mk_fwd(Args args) {
    extern __shared__ __attribute__((aligned(16))) unsigned char lds_raw[];
    LAS unsigned char* lds = (LAS unsigned char*)lds_raw;
    volatile LAS unsigned* MISC = (volatile LAS unsigned*)(lds + MISC_OFF);
    const int tid0 = threadIdx.x; const int wave_s = __builtin_amdgcn_readfirstlane(tid0 >> 6);
    const int G = gridDim.x, bx = blockIdx.x; const int vcu = (G % 8 == 0) ? (bx % 8) * (G / 8) + bx / 8 : bx;
    const int NGW = G * 8;
    unsigned char* ws = args.ws; float* out = args.out;
    unsigned* CTL = (unsigned*)(ws + WS_CTL); float* MOD = (float*)(ws + WS_MOD); float* TAB = (float*)(ws + WS_TAB);
    int* LIST = (int*)(ws + WS_MOE + MOE_LIST); float* GL = (float*)(ws + WS_MOE + MOE_GATE);
    bf16* XB = (bf16*)(ws + WS_XB); bf16* H = (bf16*)(ws + WS_H); bf16* P = (bf16*)(ws + WS_P);
    for (int u = tid0; u < (LDS_BYTES - LDSCTL_OFF) / 4; u += 512) ((LAS unsigned*)(lds + LDSCTL_OFF))[u] = 0u;
    __syncthreads();
    const int lo = args.ph_lo, hi = args.ph_hi; const bool multi = (hi - lo) > 1;
    XcdBarrier bar; bar.bar = CTL + CW_BAR + args.li * XCD_BAR_WORDS; bar.x = 0; bar.st = nullptr; bar.wv = wave_s;
    if (multi) { bar = xcd_barrier_post(CTL + CW_BAR + args.li * XCD_BAR_WORDS, MISC + 8); bar.wv = wave_s; }
#define IN(k) (lo <= (k) && (k) < hi)
#define PHASE_LOCALS const int tid_p = wave_s * 64 + lane_now(); const int lane = tid_p & 63, wave = wave_s, gw = vcu * 8 + wave, tid = tid_p; (void)lane; (void)wave; (void)gw; (void)tid; \
    unsigned char* ws_p = args.ws; asm volatile("" : "+s"(ws_p)); unsigned char* const ws = ws_p;     \
    unsigned* const CTL = (unsigned*)(ws + WS_CTL); float* const MOD = (float*)(ws + WS_MOD); float* const TAB = (float*)(ws + WS_TAB); int* const LIST = (int*)(ws + WS_MOE + MOE_LIST); float* const GL = (float*)(ws + WS_MOE + MOE_GATE); \
    bf16* const XB = (bf16*)(ws + WS_XB); bf16* const H = (bf16*)(ws + WS_H); bf16* const P = (bf16*)(ws + WS_P); (void)CTL; (void)MOD; (void)TAB; (void)LIST; (void)GL; (void)XB; (void)H; (void)P;
#define SEAM(k) do { if (multi && (k) + 1 < hi) xcd_barrier(bar); } while (0)
constexpr int QPRO = 450;
#define DEFER_Q(tot_, f0_, f1_) do { if (l < DEPTH - 1) { const int jl_ = l == 0 ? 0 : 1, qn_ = l == 0 ? 1408 - QPRO : 704, qb_ = 640 + jl_ * 1408 + (l == 2 ? 704 : l == 0 ? QPRO : 0), r_ = (tot_) % G; \
        const int a_ = qb_ + (qn_ * (f0_)) / 100, b_ = qb_ + (qn_ * (f1_)) / 100; if (r_ == 0) run_q(a_, b_, bx, G); else if (bx >= r_) run_q(a_, b_, bx - r_, G - r_); } } while (0)
#define DEFER_T(tot_) do { if (l < DEPTH - 1) { const int jl_ = l == 0 ? 0 : 1, tn_ = l == 0 ? 11264 : 5632, tb_ = 4864 + jl_ * 11264 + (l == 2 ? 5632 : 0), r_ = (tot_) % G; \
        if (r_ == 0) run_tr(tb_, tb_ + tn_, bx * 8 + wave_s, G * 8); else if (bx >= r_) run_tr(tb_, tb_ + tn_, (bx - r_) * 8 + wave_s, (G - r_) * 8); } } while (0)

    auto run_tr = [&](int lo_, int hi_, int first_, int step_) __attribute__((always_inline)) {   PHASE_LOCALS
            LAS float* scr = (LAS float*)(lds + wave * 16384);
#define P0_DEC1(it, src, dst, KK, sc8) do { sc8 = 0.f; if ((it) < 2048) { const int l_ = (it) >> 9, r2_ = (it) & 511, kb_ = r2_ >> 5, nb_ = r2_ & 31; src = args.in[9] + (size_t)l_ * D * D + (size_t)(64 * kb_) * D + 32 * nb_; \
                dst = (bf16*)((unsigned char*)(ws + WS_WOUT) + (size_t)l_ * D * D + (size_t)(32 * nb_) * D + 64 * kb_); KK = D; sc8 = f8l[4 * (18 + l_)]; } \
            else { const int it2_ = (it) - 2048, set_ = it2_ / 1408, r2_ = it2_ % 1408, kb_ = r2_ >> 5, nb_ = r2_ & 31; const bool dn_ = set_ < 2; const int si_ = dn_ ? set_ : set_ - 2; \
                src = (dn_ ? args.in[19] : args.in[24]) + (size_t)si_ * DFF * D + (size_t)(64 * kb_) * D + 32 * nb_; dst = (bf16*)((unsigned char*)(ws + (dn_ ? WS_DDN : WS_MDN)) + (size_t)si_ * D * DFF + (size_t)(32 * nb_) * DFF + 64 * kb_); KK = DFF; sc8 = f8l[4 * set_]; } } while (0)
#define P0_LOAD1(src, v) do { _Pragma("unroll") for (int i_ = 0; i_ < 8; ++i_) v[i_] = *(const f32x4*)((src) + (size_t)(8 * i_ + (lane >> 3)) * D + 4 * (lane & 7)); } while (0)
            LAS float* f8l = (LAS float*)(lds + LDSCTL_OFF + 2048);
            const float* srcC; bf16* dstC; int KC; float scC; f32x4 va[8], vb[8];
            int it = lo_ + first_; if (it < hi_) { P0_DEC1(it, srcC, dstC, KC, scC); P0_LOAD1(srcC, va); }
            for (; it < hi_; it += step_) { const float* srcN = srcC; bf16* dstN = dstC; int KN = KC; float scN = scC; const bool hn = it + step_ < hi_;
                if (hn) { P0_DEC1(it + step_, srcN, dstN, KN, scN); P0_LOAD1(srcN, vb); }
#pragma unroll
                for (int i = 0; i < 8; ++i) { const int kk = 8 * i + (lane >> 3), q4 = 4 * (lane & 7); scr[kk * 33 + q4] = va[i][0]; scr[kk * 33 + q4 + 1] = va[i][1]; scr[kk * 33 + q4 + 2] = va[i][2]; scr[kk * 33 + q4 + 3] = va[i][3]; }
                asm volatile("s_waitcnt lgkmcnt(0)" ::: "memory");
                if (scC != 0.f) {
                    const int c4 = lane & 3; unsigned char* d8 = (unsigned char*)dstC;
#pragma unroll
                    for (int j = 0; j < 2; ++j) { const int n = (lane >> 2) + 16 * j; const LAS float* sp = scr + (16 * c4) * 33 + n; int w4[4];
#pragma unroll
                        for (int q = 0; q < 4; ++q) { const float a0 = fminf(fmaxf(sp[(4 * q) * 33] * scC, -448.f), 448.f), a1 = fminf(fmaxf(sp[(4 * q + 1) * 33] * scC, -448.f), 448.f), a2 = fminf(fmaxf(sp[(4 * q + 2) * 33] * scC, -448.f), 448.f), a3 = fminf(fmaxf(sp[(4 * q + 3) * 33] * scC, -448.f), 448.f);
                            int w = 0; w = __builtin_amdgcn_cvt_pk_fp8_f32(a0, a1, w, false); w = __builtin_amdgcn_cvt_pk_fp8_f32(a2, a3, w, true); w4[q] = w; }
                        *(u32x4*)(d8 + (size_t)n * KC + 16 * c4) = (u32x4){(unsigned)w4[0], (unsigned)w4[1], (unsigned)w4[2], (unsigned)w4[3]}; }
                } else {
                const int c = lane & 7;
#pragma unroll
                for (int j = 0; j < 4; ++j) { const int n = (lane >> 3) + 8 * j; const LAS float* sp = scr + (8 * c) * 33 + n;
                    u32x4 o; o.x = pk2(sp[0 * 33], sp[1 * 33]); o.y = pk2(sp[2 * 33], sp[3 * 33]); o.z = pk2(sp[4 * 33], sp[5 * 33]); o.w = pk2(sp[6 * 33], sp[7 * 33]);
                    *(u32x4*)(dstC + (size_t)n * KC + 8 * c) = o; }
                }
                asm volatile("s_waitcnt lgkmcnt(0)" ::: "memory");
                srcC = srcN; dstC = dstN; KC = KN; scC = scN;
#pragma unroll
                for (int i = 0; i < 8; ++i) va[i] = vb[i]; }
#undef P0_DEC1
#undef P0_LOAD1
    };
    auto run_q = [&](int lo_, int hi_, int first_, int step_) __attribute__((always_inline)) {   PHASE_LOCALS
            LAS float* scr = (LAS float*)(lds + wave * 16384); LAS float* cm = (LAS float*)(lds + LDSCTL_OFF + 1024);
#define P0_DEC2(item, W, NW_, WT, cix) do { const bool isin_ = (item) >= 352 && (item) < 640; const int ff_ = (item) < 352 ? (item) : (item) - 640 + 352; const int set_ = isin_ ? 0 : ff_ / 176, r_ = isin_ ? 0 : ff_ % 176; const bool isup_ = r_ >= 88; const int lq_ = isin_ ? ((item) - 352) / 72 : 0; \
                const int nb_ = isin_ ? ((item) - 352) % 72 : (isup_ ? r_ - 88 : r_), n0_ = 32 * nb_; NW_ = isin_ ? NIN : DFF; const bool dn_ = set_ < 2; const int si_ = dn_ ? set_ : set_ - 2, pnq_ = n0_ >> 8; \
                const int drow0_ = isin_ ? (pnq_ < 3 ? 256 * pnq_ + 128 * ((n0_ >> 5) & 1) + 32 * ((n0_ >> 6) & 3) : n0_) : 256 * (n0_ >> 7) + (n0_ & 127) + (isup_ ? 128 : 0);     \
                W = (isin_ ? args.in[8] + (size_t)lq_ * D * NIN : (dn_ ? (isup_ ? args.in[18] : args.in[17]) : (isup_ ? args.in[23] : args.in[22])) + (size_t)si_ * D * DFF) + (size_t)(128 * wave) * NW_ + n0_ + 4 * (lane & 7); \
                WT = (isin_ ? (signed char*)(ws + WS_WIN) + (size_t)lq_ * NIN * D : (signed char*)(ws + (dn_ ? WS_DUP : WS_MUP)) + (size_t)si_ * NUP * D) + (size_t)drow0_ * D; cix = (isin_ ? CW_CMAX2 + lq_ * NIN : CW_CMAX + set_ * NUP) + drow0_; } while (0)
#define P0_LOAD2(W, NW_, v) do { _Pragma("unroll") for (int i_ = 0; i_ < 16; ++i_) v[i_] = *(const f32x4*)((W) + (size_t)(8 * i_ + (lane >> 3)) * (NW_)); } while (0)
            const float* WC_; int NWC; signed char* WTC; int cixC; f32x4 qa[16], qb[16];
            int item = lo_ + first_; if (item < hi_) { P0_DEC2(item, WC_, NWC, WTC, cixC); P0_LOAD2(WC_, NWC, qa); }
            for (; item < hi_; item += step_) { const float* WN_ = WC_; int NWN = NWC; signed char* WTN = WTC; int cixN = cixC; const bool hn = item + step_ < hi_;
                if (hn) { P0_DEC2(item + step_, WN_, NWN, WTN, cixN); P0_LOAD2(WN_, NWN, qb); }
                f32x4 m4 = {0.f, 0.f, 0.f, 0.f};
#pragma unroll
                for (int i = 0; i < 16; ++i) { const int kk = 8 * i + (lane >> 3); m4 = __builtin_elementwise_max(m4, __builtin_elementwise_abs(qa[i])); *(LAS f32x4*)(scr + kk * 32 + ((4 * (lane & 7) + 8 * ((kk >> 4) & 3)) & 31)) = qa[i]; }
#pragma unroll
                for (int e = 0; e < 4; ++e) { float m_ = m4[e]; m_ = fmaxf(m_, shx<8>(m_)); m_ = fmaxf(m_, shx<16>(m_)); m4[e] = max32(m_); }
                if (lane < 8) *(LAS f32x4*)(cm + wave * 32 + 4 * lane) = m4;
                __syncthreads();
                const int c = lane & 7;
                if (wave == 0 && lane < 32) { float cx = 0.f;
#pragma unroll
                    for (int w2 = 0; w2 < 8; ++w2) cx = fmaxf(cx, cm[w2 * 32 + lane]);
                    CTL[cixC + lane] = __float_as_uint(cx); }
#pragma unroll
                for (int j = 0; j < 4; ++j) { const int n = (lane >> 3) + 8 * j; float cx = 0.f;
#pragma unroll
                    for (int w2 = 0; w2 < 8; ++w2) cx = fmaxf(cx, cm[w2 * 32 + n]);
                    const float isc = cx > 0.f ? 127.0f / cx : 0.f; const LAS float* sp = scr + (16 * c) * 32 + ((n + 8 * (c & 3)) & 31); unsigned w4[4];
#pragma unroll
                    for (int q = 0; q < 4; ++q) { const int a = (int)rintf(sp[(4 * q) * 32] * isc), b2 = (int)rintf(sp[(4 * q + 1) * 32] * isc), c2 = (int)rintf(sp[(4 * q + 2) * 32] * isc), e2 = (int)rintf(sp[(4 * q + 3) * 32] * isc);
                        w4[q] = (unsigned)(a & 255) | ((unsigned)(b2 & 255) << 8) | ((unsigned)(c2 & 255) << 16) | ((unsigned)(e2 & 255) << 24); }
                    *(u32x4*)(WTC + (size_t)n * D + 128 * wave + 16 * c) = (u32x4){w4[0], w4[1], w4[2], w4[3]}; }
                __syncthreads();
                WC_ = WN_; NWC = NWN; WTC = WTN; cixC = cixN;
#pragma unroll
                for (int i = 0; i < 16; ++i) qa[i] = qb[i]; }
#undef P0_DEC2
#undef P0_LOAD2
    };
    if (IN(0)) {
        PHASE_LOCALS
        {
            LAS float* f8l = (LAS float*)(lds + LDSCTL_OFF + 2048);
            for (int set = wave; set < 22; set += 8) { const bool dn_ = set < 2, wo_ = set >= 18; const int si_ = dn_ ? set : set - 2; float bm[3];
#pragma unroll
                for (int q = 0; q < 3; ++q) { const float* W = wo_ ? args.in[9] + (size_t)(set - 18) * D * D : (q == 0 ? (dn_ ? args.in[17] : args.in[22]) : q == 1 ? (dn_ ? args.in[18] : args.in[23]) : (dn_ ? args.in[19] : args.in[24])) + (size_t)si_ * D * DFF; const int Nq = (q == 2 || wo_) ? D : DFF; float m = 0.f;
#pragma unroll
                    for (int i = 0; i < 8; ++i) { const f32x4 v = *(const f32x4*)(W + (size_t)(8 * i + (lane >> 3)) * Nq + 4 * (lane & 7)); m = fmaxf(m, fmaxf(fmaxf(fabsf(v[0]), fabsf(v[1])), fmaxf(fabsf(v[2]), fabsf(v[3])))); }
                    m = wave_max(m);
                    bm[q] = fmaxf(m, 1e-30f); }
                const float sD = 56.0f / bm[2], sA = wo_ ? SY8 : 8.0f * (3.5f / (32.0f * bm[0])) * (3.5f / (32.0f * bm[1])), dq = 1.0f / (sD * sA);
                if (lane == 0) { f8l[4 * set] = sD; f8l[4 * set + 1] = sA; f8l[4 * set + 2] = dq; if (bx == 0) { TAB[TB_F8 + 4 * set] = sD; TAB[TB_F8 + 4 * set + 1] = sA; TAB[TB_F8 + 4 * set + 2] = dq; } } }
        }
        __syncthreads();
        run_tr(0, 4864, gw, NGW);
        __syncthreads();
        run_q(0, 640 + QPRO, bx, G);
        __syncthreads();
        {   PHASE_LOCALS
            LAS float* Sl = (LAS float*)lds; LAS float* red = (LAS float*)(lds + 17 * 1024 * 4);
            const float* c = args.in[1]; const float* cctx = args.in[3];
            for (int i = tid; i < 17 * 1024; i += 512) { const float x = i < 16384 ? c[i] : cctx[i - 16384]; Sl[i] = x / (1.0f + expf(-x)); }
            __syncthreads();
            for (int item = bx; item < 4 * 96; item += G) {
                const int l = item / 96, cb = item % 96, k0 = wave * 128;
                float acc[17];
#pragma unroll
                for (int b = 0; b < 17; ++b) acc[b] = 0.f;
                const float* w = args.in[4] + ((size_t)l * 1024 + k0) * 6144 + cb * 64 + lane;
#pragma unroll 2
                for (int k = 0; k < 128; k += 4) { const float w0 = w[(size_t)k * 6144], w1 = w[(size_t)(k + 1) * 6144], w2 = w[(size_t)(k + 2) * 6144], w3 = w[(size_t)(k + 3) * 6144];
#pragma unroll
                    for (int b = 0; b < 17; ++b) { const f32x4 s4 = *(const LAS f32x4*)(Sl + b * 1024 + k0 + k); acc[b] += (s4.x * w0 + s4.y * w1) + (s4.z * w2 + s4.w * w3); } }
#pragma unroll
                for (int b = 0; b < 17; ++b) red[(wave * 17 + b) * 64 + lane] = acc[b];
                __syncthreads();
                for (int o = tid; o < 17 * 64; o += 512) { const int b = o >> 6, cl = o & 63; float s = 0.f;
#pragma unroll
                    for (int wv = 0; wv < 8; ++wv) s += red[(wv * 17 + b) * 64 + cl];
                    const int col = cb * 64 + cl, j = col >> 10, cc = col & 1023; float v = s + args.in[5][l * 6144 + col];
                    if (j == 1) v = args.in[6][l * 1024 + cc] * (1.0f + v); if (j == 4) v = args.in[7][l * 1024 + cc] * (1.0f + v);
                    MOD[(((size_t)l * 17 + b) * 6 + j) * 1024 + cc] = v; }
                __syncthreads();
            }
        }
        if (bx < 2) {
            PHASE_LOCALS
            const int t = bx * 512 + tid;
            { const int pos = t >> 4, f = t & 15; const float a = (float)pos * powf(10000.0f, -(float)f / 16.0f); TAB[TB_COSA + t] = cosf(a); TAB[TB_SINA + t] = sinf(a); }
            if (t < 512) { const int pos = t >> 3, f = t & 7; const float a = (float)pos * powf(10000.0f, -(float)f / 8.0f); TAB[TB_COSC + t] = cosf(a); TAB[TB_SINC + t] = sinf(a); }
            if (t < 4) { const float* p = args.in[15] + t * 128; float s1 = 0.f, s2 = 0.f; for (int i = 0; i < 32; ++i) { s1 += p[i] * p[32 + i]; s2 += p[64 + i] * p[96 + i]; }
                const float li = 0.8f - 0.6f * expf(-0.3f * (float)t); TAB[TB_LAM + t] = expf(s1) - expf(s2) + li; TAB[TB_LAM + 4 + t] = 1.0f - li; }
        }
        SEAM(0);
    }
    for (int l = 0; l < DEPTH; ++l) {
        const int pb = PH_L0 + PH_PER_LAYER * l; const bool lastl = l == DEPTH - 1; const int mr = lastl ? ML : MT; const int li = l >> 1;
        const float* MODl = MOD + (size_t)l * 17 * 6144;
        if (IN(pb + PH_NORM1)) {
            PHASE_LOCALS
            NormArgs a{args.in[0], args.in[2], l == 0 ? nullptr : XB, MODl, 1, 0, (bf16*)(ws + WS_H8A), MT, nullptr, nullptr, nullptr, nullptr, nullptr, (float*)(ws + WS_RS), nullptr, (l > 0 && (l & 1) == 0) ? H : nullptr, XB};
            const int rpw = MT / NGW; norm_rows(a, gw * rpw, rpw, lane);
            SEAM(pb + PH_NORM1);
        }
        if (IN(pb + PH_INPROJ)) {
            pg8::InprojSched S{(const char*)(ws + WS_H8A), (const char*)(ws + WS_WIN) + (size_t)l * NIN * D, D / 2, MT / 256, NIN / 256, G, bx, lastl};
            pg8::EpiInprojT<true> E{P, TAB, args.in[10] + l * 64, args.in[11] + l * 64, args.in[12] + l * 32, args.in[13] + l * 32, (const float*)(ws + WS_RS), CTL + CW_CMAX2 + l * NIN};
            pg8::gemm_phase<pg8::EpiInprojT<true>, pg8::InprojSched, true>(lds, S, E, wave_s);
            DEFER_Q((MT / 256) * (NIN / 256), 0, 34);
            SEAM(pb + PH_INPROJ);
        }
        if (IN(pb + PH_ATTN)) {
            static_assert(attn_body::ATTN_LDS_BYTES <= RING_BYTES, "attention LDS");
            char* shm = (char*)lds_raw; unsigned char* const HB = (unsigned char*)H;
            { PHASE_LOCALS const int rpw = mr / NGW; conv_rows(P, HB, args.in[14] + l * 768, gw * rpw, rpw, lane); }
            const float lam = TAB[TB_LAM + l], oml = TAB[TB_LAM + 4 + l]; const float* sub = args.in[16] + l * 64;
#pragma unroll 1
            for (int i = 0; i < 4; ++i) { const int ua = vcu * 4 + i, qb = ua & 7, hq = (ua >> 3) & 7, b = ua >> 6, kv = hq >> 2; const size_t qrow0 = (size_t)b * SEQ + qb * 256, krow0 = (size_t)b * SEQ;
                const long dC = ((long)ML + b * CTX - (long)b * SEQ - SEQ) * NIN;
                attn_body::attn_unit<8, 0>(P + qrow0 * NIN + hq * 64, P + krow0 * NIN + 512 + kv * 64, P + krow0 * NIN + 640 + kv * 64, dC, 32, 36, HB + qrow0 * D + hq * 64, 0.f, 0.f, sub, shm, wave_s); }
#pragma unroll 1
            for (int i = 0; i < 2; ++i) { const int uc = vcu * 2 + i, qb = uc & 7, hd = (uc >> 3) & 3, b = uc >> 5; const size_t qrow0 = (size_t)b * SEQ + qb * 256, krow0 = (size_t)b * SEQ;
                const long dC = ((long)ML + b * CTX - (long)b * SEQ - SEQ) * NIN;
                attn_body::attn_unit<8, 1>(P + qrow0 * NIN + 1536 + hd * 64, P + krow0 * NIN + 1792 + hd * 64, P + krow0 * NIN + 2048 + hd * 64, dC, 32, 36, HB + qrow0 * D + 768 + hd * 64, lam, oml, sub, shm, wave_s);
                attn_body::attn_unit<8, 2>(P + qrow0 * NIN + 1536 + hd * 64 + 32, P + krow0 * NIN + 1792 + hd * 64, P + krow0 * NIN + 2048 + hd * 64, dC, 32, 36, HB + qrow0 * D + 768 + hd * 64, lam, oml, sub, shm, wave_s); }
            if (!lastl) {
                if (vcu < 128) { const int b = vcu >> 3, hq = vcu & 7, kv = hq >> 2; const size_t qrow0 = (size_t)ML + b * CTX;
                    attn_body::attn_unit<8, 0>(P + qrow0 * NIN + hq * 64, P + qrow0 * NIN + 512 + kv * 64, P + qrow0 * NIN + 640 + kv * 64, 0l, 4, 4, HB + qrow0 * D + hq * 64, 0.f, 0.f, sub, shm, wave_s); }
                else if (vcu < 192) { const int j = vcu - 128, b = j >> 2, hd = j & 3; const size_t qrow0 = (size_t)ML + b * CTX;
                    attn_body::attn_unit<8, 1>(P + qrow0 * NIN + 1536 + hd * 64, P + qrow0 * NIN + 1792 + hd * 64, P + qrow0 * NIN + 2048 + hd * 64, 0l, 4, 4, HB + qrow0 * D + 768 + hd * 64, lam, oml, sub, shm, wave_s);
                    attn_body::attn_unit<8, 2>(P + qrow0 * NIN + 1536 + hd * 64 + 32, P + qrow0 * NIN + 1792 + hd * 64, P + qrow0 * NIN + 2048 + hd * 64, 0l, 4, 4, HB + qrow0 * D + 768 + hd * 64, lam, oml, sub, shm, wave_s); }
            }
            SEAM(pb + PH_ATTN);
        }
        if (IN(pb + PH_OUTPROJ)) {
            pg8::DenseSched S{(const char*)H, (const char*)(ws + WS_WOUT) + (size_t)l * D * D, D / 2, mr / 256, D / 256, G, bx};
            pg8::EpiResT<true> E{l == 0 ? args.in[0] : nullptr, args.in[2], XB, MODl, 2, TAB[TB_F8 + 4 * (18 + l) + 2]};
            pg8::gemm_phase<pg8::EpiResT<true>, pg8::DenseSched, true>(lds, S, E, wave_s);
            DEFER_Q((mr / 256) * (D / 256), 34, 71);
            SEAM(pb + PH_OUTPROJ);
        }
        if ((l & 1) == 0) {
            if (IN(pb + PH_NORM2)) {
                PHASE_LOCALS
                NormArgs a{nullptr, nullptr, XB, MODl, 4, 3, H, mr, nullptr, nullptr, nullptr, nullptr, nullptr, (float*)(ws + WS_RS), nullptr, nullptr, nullptr};
                const int rpw = mr / NGW; norm_rows(a, gw * rpw, rpw, lane);
                SEAM(pb + PH_NORM2);
            }
            if (IN(pb + PH_UP0)) {
                pg8::DenseSched S{(const char*)H, (const char*)(ws + WS_DUP) + (size_t)li * NUP * D, D / 2, mr / 256, NUP / 256, G, bx};
                pg8::EpiSwigluI8 E{(unsigned char*)P, DFF, (const float*)(ws + WS_RS), CTL + CW_CMAX + li * NUP, 0, false, TAB + TB_F8, li};
                pg8::gemm_phase<pg8::EpiSwigluI8, pg8::DenseSched, true>(lds, S, E, wave_s);
                DEFER_Q((mr / 256) * (NUP / 256), 71, 100);
                SEAM(pb + PH_UP0);
            }
            if (IN(pb + PH_DN0)) {
                pg8::DenseSched S{(const char*)P, (const char*)(ws + WS_DDN) + (size_t)li * D * DFF, DFF / 2, mr / 256, D / 256, G, bx};
                pg8::EpiResT<true> E{nullptr, nullptr, XB, MODl, 5, TAB[TB_F8 + 4 * li + 2]};
                pg8::gemm_phase<pg8::EpiResT<true>, pg8::DenseSched, true>(lds, S, E, wave_s);
                DEFER_T((mr / 256) * (D / 256));
                SEAM(pb + PH_DN0);
            }
        } else {
            unsigned* cnt = CTL + CW_CNT + 64 * li;
            if (IN(pb + PH_NORM2)) {
                PHASE_LOCALS
                NormArgs a{nullptr, nullptr, XB, MODl, 4, 3, H, mr, args.in[20] + (size_t)li * D * NE, args.in[21] + li * NE, cnt, LIST, GL, (float*)(ws + WS_RS), (float*)(ws + WS_RSL), nullptr, nullptr};
                norm2_router_phase(a, lds, vcu, NGW, tid, lane, wave);
                SEAM(pb + PH_NORM2);
            }
            if (IN(pb + PH_UP0)) {
                pg8::MoeSched<true> S; S.A = (const char*)H; S.Bt = (const char*)(ws + WS_MUP) + (size_t)li * NE * NUP * D; S.estride = (size_t)NUP * D; S.K = D / 2; S.nN = NUP / 256; S.G = G; S.c = bx;
                S.list = LIST; S.init_counts(cnt);
                pg8::EpiSwigluI8 E{(unsigned char*)P, DFF, (const float*)(ws + WS_RSL), CTL + CW_CMAX + (2 + li * NE) * NUP, NUP, true, TAB + TB_F8, 2 + li * NE};
                pg8::gemm_phase<pg8::EpiSwigluI8, pg8::MoeSched<true>, true>(lds, S, E, wave_s);
                { int tp_ = 0;
#pragma unroll
                  for (int j = 0; j < 16; ++j) tp_ += (S.cn[j] + 255) >> 8;
                  DEFER_Q(tp_ * (NUP / 256), 71, 100); }
                SEAM(pb + PH_UP0);
            }
            if (IN(pb + PH_DN0)) {
                pg8::MoeSched<false> S; S.A = (const char*)P; S.Bt = (const char*)(ws + WS_MDN) + (size_t)li * NE * D * DFF; S.estride = (size_t)D * DFF; S.K = DFF / 2; S.nN = D / 256; S.G = G; S.c = bx;
                S.list = LIST; S.init_counts(cnt);
                pg8::EpiMoeDown E{XB, MODl, 5, LIST, GL, H, TAB + TB_F8, 2 + li * NE};
                pg8::gemm_phase<pg8::EpiMoeDown, pg8::MoeSched<false>, true>(lds, S, E, wave_s);
                { int tp_ = 0;
#pragma unroll
                  for (int j = 0; j < 16; ++j) tp_ += (S.cn[j] + 255) >> 8;
                  DEFER_T(tp_ * (D / 256)); }
                SEAM(pb + PH_DN0);
            }
        }
    }
    if (IN(PH_FINAL)) {
        PHASE_LOCALS
        const int rpw = ML / NGW;
        u32x2 xn[4], yn[4];
#pragma unroll
        for (int j = 0; j < 4; ++j) { xn[j] = ((const u32x2*)(XB + (size_t)(gw * rpw) * D))[lane + 64 * j]; yn[j] = ((const u32x2*)(H + (size_t)(gw * rpw) * D))[lane + 64 * j]; }
        for (int i = 0; i < rpw; ++i) { const int row = gw * rpw + i; float* xr = out + (size_t)row * D; u32x2 x[4], y[4];
#pragma unroll
            for (int j = 0; j < 4; ++j) { x[j] = xn[j]; y[j] = yn[j]; }
            if (i + 1 < rpw) {
#pragma unroll
                for (int j = 0; j < 4; ++j) { xn[j] = ((const u32x2*)(XB + (size_t)(row + 1) * D))[lane + 64 * j]; yn[j] = ((const u32x2*)(H + (size_t)(row + 1) * D))[lane + 64 * j]; } }
#pragma unroll
            for (int j = 0; j < 4; ++j) { f32x4 a, c; unpack4(x[j], a); unpack4(y[j], c); *(f32x4*)(xr + 4 * lane + 256 * j) = a + c; } }
    }
#undef IN
#undef SEAM
}
static void launch_mk(const Args& a0, int lo, int hi, int grid, hipStream_t s) { Args a = a0; a.ph_lo = lo; a.ph_hi = hi; a.li = 0; a.pad = 0;
    hipLaunchKernelGGL(mk_fwd, dim3(grid), dim3(512), LDS_BYTES, s, a); }
extern "C" void kernel_launch(void* const* d_in, const int* in_sizes, int n_in, void* d_out, int out_size, void* d_ws, size_t ws_size, hipStream_t stream) {
    static int grid = 0;
    if (grid == 0) {
        if (n_in != 25 || out_size != ML * D || ws_size < WS_END) { fprintf(stderr, "kernel_launch: unexpected shapes (n_in %d out %d ws %zu)\n", n_in, out_size, ws_size); grid = -1; return; }
        int dev = 0, cus = 0, per_cu = 0;
        if (hipGetDevice(&dev) != hipSuccess || hipDeviceGetAttribute(&cus, hipDeviceAttributeMultiprocessorCount, dev) != hipSuccess) { grid = -1; return; }
        if (hipFuncSetAttribute((const void*)mk_fwd, hipFuncAttributeMaxDynamicSharedMemorySize, LDS_BYTES) != hipSuccess) { fprintf(stderr, "kernel_launch: hipFuncSetAttribute failed\n"); grid = -1; return; }
        if (hipOccupancyMaxActiveBlocksPerMultiprocessor(&per_cu, (const void*)mk_fwd, 512, LDS_BYTES) != hipSuccess || per_cu < 1) { fprintf(stderr, "kernel_launch: occupancy query says %d\n", per_cu); }
        (void)hipGetLastError();
        grid = cus;
        if (grid != 256) { fprintf(stderr, "kernel_launch: built for 256 CUs, device has %d\n", cus); grid = -1; return; }
    }
    if (grid < 0) return;
    unsigned char* ws = (unsigned char*)d_ws; float* out = (float*)d_out;
    (void)hipMemsetAsync(ws + WS_CTL, 0, 1 * MiB, stream);
    Args A{}; for (int i = 0; i < 25; ++i) A.in[i] = (const float*)d_in[i]; A.out = out; A.ws = ws;
    launch_mk(A, 0, N_PHASES, grid, stream);
}
```
